# Optimizing an MI355X kernel written in HIP

```python
import jax, jax.numpy as jnp
from jax import lax
import numpy as np

D_MODEL = 1024
BATCH = 4
SEQ = 8192
DEPTH = 4

CHUNK = 64
N_MEM = 256
D_MIX = D_MODEL
D_A = D_MIX // 2
D_B = D_MIX - D_A
HGRN_KDIM = 128
HGRN_HEADS = D_A // HGRN_KDIM
HGRN_VDIM = D_A // HGRN_HEADS
POOL_WINDOWS = (2, 4, 8, 16)
POOL_GROUPS = len(POOL_WINDOWS)
POOL_CH = D_B // POOL_GROUPS
D_IN = 4 * D_A + D_B
D_FF = ((8 * D_MODEL // 3) + 127) // 128 * 128
XA_HEADS = 4
XA_HEAD_DIM = D_MODEL // XA_HEADS
EPS = 1e-6

kernel_name = 'hymba_hgrn2_pool_macaron_memxattn'


def rmsnorm(x, g):
    xf = x.astype(jnp.float32)
    y = xf * lax.rsqrt(jnp.mean(xf * xf, axis=-1, keepdims=True) + EPS)
    return (y * g.astype(jnp.float32)).astype(x.dtype)


def swiglu(h, w1, w3, w2):
    return (jax.nn.silu(h @ w1) * (h @ w3)) @ w2


def hgrn2_chunkwise(q, k, v, log_f):
    B, T, H, K = q.shape
    V = v.shape[-1]
    nc = T // CHUNK

    def to_chunks(a):
        return a.reshape(B, nc, CHUNK, H, a.shape[-1]).transpose(1, 0, 3, 2, 4)

    causal = jnp.tril(jnp.ones((CHUNK, CHUNK), dtype=bool))[:, :, None]

    def step(S, inp):
        qc, kc, vc, gc = inp
        b = jnp.cumsum(gc, axis=2)
        o_inter = jnp.einsum('bhtk,bhkv->bhtv', qc * jnp.exp(b), S)
        rel = b[:, :, :, None, :] - b[:, :, None, :, :]
        decay = jnp.exp(jnp.where(causal, rel, -jnp.inf))
        A = jnp.einsum('bhtk,bhsk,bhtsk->bhts', qc, kc, decay)
        o = o_inter + jnp.einsum('bhts,bhsv->bhtv', A, vc)
        b_last = b[:, :, -1:, :]
        S = jnp.exp(b_last[:, :, 0, :, None]) * S + jnp.einsum(
            'bhsk,bhsv->bhkv', kc * jnp.exp(b_last - b), vc)
        return S, o

    S0 = jnp.zeros((B, H, K, V), jnp.float32)
    _, o = lax.scan(step, S0, (to_chunks(q), to_chunks(k), to_chunks(v), to_chunks(log_f)))
    return o.transpose(1, 0, 3, 2, 4).reshape(B, T, H, V)


def hgrn2_mixer(q_in, f_in, i_in, g_in, lb, norm_g):
    B, T, _ = q_in.shape
    shp = (B, T, HGRN_HEADS, HGRN_KDIM)
    q = q_in.astype(jnp.float32).reshape(shp)
    z = f_in.astype(jnp.float32).reshape(shp)
    lbh = lb.reshape(HGRN_HEADS, HGRN_KDIM)
    log_f = jnp.logaddexp(jnp.log(lbh), jnp.log1p(-lbh) + jax.nn.log_sigmoid(z))
    k = (1.0 - lbh) * jax.nn.sigmoid(-z)
    v = i_in.astype(jnp.float32).reshape(B, T, HGRN_HEADS, HGRN_VDIM)
    o = hgrn2_chunkwise(q, k, v, log_f)
    o = o * lax.rsqrt(jnp.mean(o * o, axis=-1, keepdims=True) + EPS)
    o = o * norm_g.astype(jnp.float32).reshape(HGRN_HEADS, HGRN_VDIM)
    o = o.reshape(B, T, D_A) * jax.nn.silu(g_in.astype(jnp.float32))
    return o.astype(q_in.dtype)


def multiscale_pool(u, pool_w, pool_scale):
    B, T, _ = u.shape
    uf = u.astype(jnp.float32).reshape(B, T, POOL_GROUPS, POOL_CH)
    cs = jnp.cumsum(uf, axis=1)
    t_count = jnp.arange(1, T + 1, dtype=jnp.float32)
    outs = []
    for j, w in enumerate(POOL_WINDOWS):
        csj = cs[:, :, j]
        prev = jnp.pad(csj, ((0, 0), (w, 0), (0, 0)))[:, :T]
        mean = (csj - prev) / jnp.minimum(t_count, w)[None, :, None]
        outs.append(mean - uf[:, :, j])
    p = jnp.stack(outs, axis=2)
    y = jnp.einsum('btgc,gcd->btgd', p, pool_w.astype(jnp.float32)).reshape(B, T, D_B)
    return (y * pool_scale.astype(jnp.float32)).astype(u.dtype)


def mem_cross_attention(h, mem_n, wq, wkv, wo):
    B, T, _ = h.shape
    M = mem_n.shape[1]
    q = (h @ wq).reshape(B, T, XA_HEADS, XA_HEAD_DIM)
    kv = (mem_n @ wkv).reshape(B, M, 2, XA_HEADS, XA_HEAD_DIM)
    k, v = kv[:, :, 0], kv[:, :, 1]
    s = jnp.einsum('bthd,bmhd->bhtm', q, k).astype(jnp.float32) * (XA_HEAD_DIM ** -0.5)
    p = jax.nn.softmax(s, axis=-1).astype(h.dtype)
    o = jnp.einsum('bhtm,bmhd->bthd', p, v).reshape(B, T, D_MODEL)
    return o @ wo


def setup_inputs(seed: int = 0) -> dict:
    key = jax.random.key(seed)
    ks = jax.random.split(key, 24)
    f32 = jnp.float32

    def nrm(k, shape, scale):
        return jax.random.normal(k, shape, f32) * scale

    def gain(k, shape):
        return 1.0 + 0.1 * jax.random.normal(k, shape, f32)

    L, D, F = DEPTH, D_MODEL, D_FF
    return {
        'x': nrm(ks[0], (BATCH, SEQ, D), 1.0),
        'mem': nrm(ks[1], (BATCH, N_MEM, D), 1.0),
        'ffn1_norm': gain(ks[2], (L, D)),
        'ffn1_w1': nrm(ks[3], (L, D, F), D ** -0.5),
        'ffn1_w3': nrm(ks[4], (L, D, F), D ** -0.5),
        'ffn1_w2': nrm(ks[5], (L, F, D), F ** -0.5),
        'mix_norm': gain(ks[6], (L, D)),
        'w_in': nrm(ks[7], (L, D, D_IN), D ** -0.5),
        'lb_logits': nrm(ks[8], (L, D_A), 1.0),
        'hgrn_norm': gain(ks[9], (L, D_A)),
        'pool_w': nrm(ks[10], (L, POOL_GROUPS, POOL_CH, POOL_CH), POOL_CH ** -0.5),
        'pool_scale': gain(ks[11], (L, D_B)),
        'w_out': nrm(ks[12], (L, D_MIX, D), D_MIX ** -0.5),
        'xa_norm': gain(ks[13], (L, D)),
        'mem_norm': gain(ks[14], (L, D)),
        'xa_wq': nrm(ks[15], (L, D, D), D ** -0.5),
        'xa_wkv': nrm(ks[16], (L, D, 2 * D), D ** -0.5),
        'xa_wo': nrm(ks[17], (L, D, D), D ** -0.5),
        'ffn2_norm': gain(ks[18], (L, D)),
        'ffn2_w1': nrm(ks[19], (L, D, F), D ** -0.5),
        'ffn2_w3': nrm(ks[20], (L, D, F), D ** -0.5),
        'ffn2_w2': nrm(ks[21], (L, F, D), F ** -0.5),
        'final_norm': gain(ks[22], (D,)),
    }


def reference(x, mem, ffn1_norm, ffn1_w1, ffn1_w3, ffn1_w2, mix_norm, w_in, lb_logits,
              hgrn_norm, pool_w, pool_scale, w_out, xa_norm, mem_norm, xa_wq, xa_wkv,
              xa_wo, ffn2_norm, ffn2_w1, ffn2_w3, ffn2_w2, final_norm):
    lb_all = jnp.cumsum(jax.nn.softmax(lb_logits.astype(jnp.float32), axis=0), axis=0)
    lb_all = lb_all - lb_all[0:1]
    splits = [D_A, 2 * D_A, 3 * D_A, 4 * D_A]
    for l in range(DEPTH):
        x = x + 0.5 * swiglu(rmsnorm(x, ffn1_norm[l]), ffn1_w1[l], ffn1_w3[l], ffn1_w2[l])
        h = rmsnorm(x, mix_norm[l])
        proj = h @ w_in[l]
        q_a, f_a, i_a, g_a, u_b = jnp.split(proj, splits, axis=-1)
        o_a = hgrn2_mixer(q_a, f_a, i_a, g_a, lb_all[l], hgrn_norm[l])
        o_b = multiscale_pool(u_b, pool_w[l], pool_scale[l])
        x = x + jnp.concatenate([o_a, o_b], axis=-1) @ w_out[l]
        x = x + mem_cross_attention(rmsnorm(x, xa_norm[l]), rmsnorm(mem, mem_norm[l]),
                                    xa_wq[l], xa_wkv[l], xa_wo[l])
        x = x + 0.5 * swiglu(rmsnorm(x, ffn2_norm[l]), ffn2_w1[l], ffn2_w3[l], ffn2_w2[l])
    return rmsnorm(x, final_norm)
```

```cpp
#include <hip/hip_runtime.h>
#include <hip/hip_cooperative_groups.h>
#include <cstdio>
namespace cg = cooperative_groups;
namespace pg8 {
#define PG8_LAS __attribute__((address_space(3)))
typedef unsigned short bf16_t;
typedef short bf16x8 __attribute__((ext_vector_type(8)));
typedef float f32x4 __attribute__((ext_vector_type(4)));
typedef unsigned u32x4 __attribute__((ext_vector_type(4)));
constexpr int BM = 256, BK = 64, HALF = 128, HTB = HALF * BK * 2  , STAGE_BYTES = 8 * HTB, NXCD = 8, WGM = 8;

__host__ __device__ __forceinline__ int lds_byte(int r, int c) { const int st = (r >> 4) * 2 + (c >> 5), rr = r & 15, cc = c & 31, ob = rr * 64 + cc * 2; return st * 1024 + (ob ^ (((ob >> 9) & 1) << 5)); }
__host__ __device__ __forceinline__ void stage_rc(int b, int& R, int& C) { const int st = b / 1024, sb = b % 1024, swz = sb ^ (((sb >> 9) & 1) << 5); R = (st >> 1) * 16 + swz / 64; C = (st & 1) * 32 + (swz % 64) / 2; }
__host__ __device__ __forceinline__ int perm32(int rho) { const int n = rho >> 4, i = rho & 15; return 8 * (i >> 2) + 4 * n + (i & 3); }

struct Unit { int pm, pn; };
struct Gemm { const bf16_t* A; const bf16_t* Bt; int M, N, K; };

struct StaticOrder {
    int nM, nN, nwg, G, c;
    __host__ __device__ void init(int M, int N, int G_, int c_) { nM = M / BM; nN = N / BM; nwg = nM * nN; G = G_; c = c_; }
    __host__ __device__ __forceinline__ bool next(int i, Unit& u) const {
        const long L = (long)i * G + c; if (L >= nwg) return false;
        int wgid = (int)L; { const int q = nwg / NXCD, r = nwg % NXCD, xcd = wgid % NXCD, off = wgid / NXCD; wgid = (xcd < r ? xcd * (q + 1) : r * (q + 1) + (xcd - r) * q) + off; }
        const int nig = WGM * nN, gid = wgid / nig, fm = gid * WGM, gsz = (nM - fm) < WGM ? (nM - fm) : WGM;
        u.pm = fm + ((wgid % nig) % gsz); u.pn = (wgid % nig) / gsz; return true;
    }
    __device__ __forceinline__ void a_ready(const Unit&) const {}
    __device__ __forceinline__ void done(const Unit&) const {}
};

__device__ __forceinline__ unsigned cvt_pk_bf16(float lo, float hi) { unsigned r; asm volatile("v_cvt_pk_bf16_f32 %0, %1, %2" : "=v"(r) : "v"(lo), "v"(hi)); return r; }
template <class Epi, class Sched, bool ALIGN_EPI = false, bool SP2 = false>
__device__ __forceinline__ void gemm_phase(PG8_LAS unsigned char* lds, const Gemm g, const Sched& S, const Epi& E) {
    int tid_ = threadIdx.x; asm volatile("" : "+v"(tid_));
    const int tid = tid_, wid = __builtin_amdgcn_readfirstlane(tid >> 6), lane = tid & 63, wr = wid >> 2, wc = wid & 3, fr = lane & 15, fq = lane >> 4;
    const int K = g.K, nt = K / BK;
    unsigned voffA[2], voffB[2];
#pragma unroll
    for (int i = 0; i < 2; ++i) { int R, C; stage_rc(tid * 16 + i * 8192, R, C); const int Rb = Epi::PERM ? ((R & ~31) + perm32(R & 31)) : R;
        voffA[i] = (unsigned)(R * K + C) * 2u; voffB[i] = (unsigned)(Rb * K + C) * 2u; }
    const size_t kstep = (size_t)(BK * 2);
    const size_t hstep = (size_t)HALF * K * 2;
    const size_t tstep = 2 * hstep;
    const unsigned ldsw = (unsigned)wid * 1024u;
    const int aoff = lds_byte(wr * 64 + fr, fq * 8), boff = lds_byte(wc * 32 + fr, fq * 8);
#define PG8_SA(b, h) (((b) * 2 + (h)) * HTB)
#define PG8_SB(b, h) ((4 + (b) * 2 + (h)) * HTB)
#define PG8_STAGE(bufoff, gbase, voff) do { _Pragma("unroll") for (int _i = 0; _i < 2; ++_i) \
        __builtin_amdgcn_global_load_lds((const unsigned*)((const char*)(gbase) + (voff)[_i]), (PG8_LAS unsigned*)(lds + (bufoff) + ldsw + _i * 8192), 16, 0, 0); } while (0)
#define PG8_LDA(dst, b, h) do { _Pragma("unroll") for (int m = 0; m < 4; ++m) _Pragma("unroll") for (int k = 0; k < 2; ++k) dst[m][k] = *(const PG8_LAS bf16x8*)(lds + PG8_SA(b, h) + aoff + m * 2048 + k * 1024); } while (0)
#define PG8_LDB(dst, b, h) do { _Pragma("unroll") for (int n = 0; n < 2; ++n) _Pragma("unroll") for (int k = 0; k < 2; ++k) dst[n][k] = *(const PG8_LAS bf16x8*)(lds + PG8_SB(b, h) + boff + n * 2048 + k * 1024); } while (0)
#define PG8_MMA(ai, bj, At, Bt) do { __builtin_amdgcn_s_setprio(1); _Pragma("unroll") for (int m = 0; m < 4; ++m) _Pragma("unroll") for (int n = 0; n < 2; ++n) _Pragma("unroll") for (int k = 0; k < 2; ++k) \
        acc[ai][bj][m][n] = __builtin_amdgcn_mfma_f32_16x16x32_bf16(Bt[n][k], At[m][k], acc[ai][bj][m][n], 0, 0, 0); __builtin_amdgcn_s_setprio(0); } while (0)
#define PG8_WAIT_V(n) asm volatile("s_waitcnt vmcnt(" #n ")" ::: "memory")
#define PG8_WAIT_L(n) asm volatile("s_waitcnt lgkmcnt(" #n ")" ::: "memory")
#define PG8_BAR __builtin_amdgcn_s_barrier()
#define PG8_SCHED __builtin_amdgcn_sched_barrier(0)
    Unit cur, nxt; int ui = 0;
    if (!S.next(0, cur)) return;
    typename Epi::State est;
    f32x4 acc[2][2][4][2];
#pragma unroll
    for (int a = 0; a < 2; ++a)
#pragma unroll
        for (int b = 0; b < 2; ++b)
#pragma unroll
            for (int m = 0; m < 4; ++m)
#pragma unroll
                for (int n = 0; n < 2; ++n) acc[a][b][m][n] = (f32x4){0.f, 0.f, 0.f, 0.f};
    bf16x8 At[4][2], B0[2][2], B1[2][2];
    const char* cA = (const char*)g.A + (size_t)cur.pm * tstep; const char* cB = (const char*)g.Bt + (size_t)cur.pn * tstep;
    S.a_ready(cur);
    if constexpr (SP2) {
        PG8_STAGE(PG8_SB(0, 0), cB, voffB); PG8_STAGE(PG8_SB(0, 1), cB + hstep, voffB); PG8_STAGE(PG8_SA(0, 0), cA, voffA); PG8_STAGE(PG8_SA(0, 1), cA + hstep, voffA);
        if (wr == 1) PG8_BAR;
        PG8_WAIT_V(2); PG8_BAR;
        PG8_STAGE(PG8_SB(1, 0), cB + kstep, voffB); PG8_STAGE(PG8_SA(1, 0), cA + kstep, voffA); PG8_STAGE(PG8_SB(1, 1), cB + hstep + kstep, voffB);
        PG8_WAIT_V(6); PG8_BAR;
    } else {
        PG8_STAGE(PG8_SB(0, 0), cB, voffB); PG8_STAGE(PG8_SA(0, 0), cA, voffA); PG8_STAGE(PG8_SB(0, 1), cB + hstep, voffB); PG8_STAGE(PG8_SA(0, 1), cA + hstep, voffA);
        if (wr == 1) PG8_BAR;
        PG8_WAIT_V(4); PG8_BAR;
        PG8_STAGE(PG8_SB(1, 0), cB + kstep, voffB); PG8_STAGE(PG8_SA(1, 0), cA + kstep, voffA); PG8_STAGE(PG8_SB(1, 1), cB + hstep + kstep, voffB);
        PG8_WAIT_V(6); PG8_BAR;
    }
    for (;;) {
        const bool has_next = S.next(ui + 1, nxt);
        const char* nA = has_next ? (const char*)g.A + (size_t)nxt.pm * tstep : cA; const char* nB = has_next ? (const char*)g.Bt + (size_t)nxt.pn * tstep : cB;
        for (int t = 0; t < nt; t += 2) {
            const bool last = (t == nt - 2);
            const char* a1 = cA + (size_t)(t + 1) * kstep;
            const char* a2 = last ? nA : cA + (size_t)(t + 2) * kstep; const char* b2 = last ? nB : cB + (size_t)(t + 2) * kstep;
            const char* a3 = a2 + kstep; const char* b3 = b2 + kstep;
            if (last && has_next) S.a_ready(nxt);
            if constexpr (SP2) {
            PG8_LDB(B0, 0, 0); PG8_LDB(B1, 0, 1); PG8_SCHED; PG8_LDA(At, 0, 0); PG8_STAGE(PG8_SA(1, 1), a1 + hstep, voffA);
            PG8_WAIT_V(8); PG8_WAIT_L(0); PG8_BAR; PG8_MMA(0, 0, At, B0); PG8_MMA(0, 1, At, B1); PG8_BAR; PG8_SCHED;
            PG8_LDA(At, 0, 1); PG8_STAGE(PG8_SB(0, 0), b2, voffB); PG8_STAGE(PG8_SB(0, 1), b2 + hstep, voffB); PG8_STAGE(PG8_SA(0, 0), a2, voffA);
            PG8_WAIT_V(8); PG8_WAIT_L(0); PG8_BAR; PG8_MMA(1, 0, At, B0); PG8_MMA(1, 1, At, B1); PG8_BAR; PG8_SCHED;
            PG8_LDB(B0, 1, 0); PG8_LDB(B1, 1, 1); PG8_SCHED; PG8_LDA(At, 1, 0); PG8_STAGE(PG8_SA(0, 1), a2 + hstep, voffA);
            PG8_WAIT_V(8); PG8_WAIT_L(0); PG8_BAR; PG8_MMA(0, 0, At, B0); PG8_MMA(0, 1, At, B1); PG8_BAR; PG8_SCHED;
            PG8_LDA(At, 1, 1); PG8_STAGE(PG8_SB(1, 0), b3, voffB); PG8_STAGE(PG8_SB(1, 1), b3 + hstep, voffB); PG8_STAGE(PG8_SA(1, 0), a3, voffA);
            PG8_WAIT_V(8); PG8_WAIT_L(0); PG8_BAR; PG8_MMA(1, 0, At, B0); PG8_MMA(1, 1, At, B1); PG8_BAR; PG8_SCHED;
            } else {
            PG8_LDB(B0, 0, 0); PG8_SCHED; PG8_LDA(At, 0, 0); PG8_STAGE(PG8_SA(1, 1), a1 + hstep, voffA);
            PG8_WAIT_L(8); PG8_BAR; PG8_WAIT_L(0); PG8_MMA(0, 0, At, B0); PG8_BAR; PG8_SCHED;
            PG8_LDB(B1, 0, 1); PG8_STAGE(PG8_SB(0, 0), b2, voffB);
            PG8_BAR; PG8_WAIT_L(0); PG8_MMA(0, 1, At, B1); PG8_BAR;
            PG8_LDA(At, 0, 1); PG8_STAGE(PG8_SA(0, 0), a2, voffA);
            PG8_BAR; PG8_WAIT_L(0); PG8_MMA(1, 0, At, B0); PG8_BAR; PG8_SCHED;
            PG8_STAGE(PG8_SB(0, 1), b2 + hstep, voffB);
            PG8_WAIT_V(6); PG8_BAR; PG8_MMA(1, 1, At, B1); PG8_BAR;
            PG8_LDB(B0, 1, 0); PG8_SCHED; PG8_LDA(At, 1, 0); PG8_STAGE(PG8_SA(0, 1), a2 + hstep, voffA);
            PG8_WAIT_L(8); PG8_BAR; PG8_WAIT_L(0); PG8_MMA(0, 0, At, B0); PG8_BAR; PG8_SCHED;
            PG8_LDB(B1, 1, 1); PG8_STAGE(PG8_SB(1, 0), b3, voffB);
            PG8_BAR; PG8_WAIT_L(0); PG8_MMA(0, 1, At, B1); PG8_BAR;
            PG8_LDA(At, 1, 1); PG8_STAGE(PG8_SA(1, 0), a3, voffA);
            PG8_BAR; PG8_WAIT_L(0); PG8_MMA(1, 0, At, B0); PG8_BAR; PG8_SCHED;
            PG8_STAGE(PG8_SB(1, 1), b3 + hstep, voffB);
            PG8_WAIT_V(6); PG8_BAR; PG8_MMA(1, 1, At, B1); PG8_BAR;
            }
        }
        if constexpr (ALIGN_EPI) { if (wr == 0) PG8_BAR; }
        if constexpr (!Epi::AFTER_DRAIN) { E(acc, cur, wr, wc, fr, fq, est); S.done(cur); }
        if (!has_next) break;
#pragma unroll
        for (int a = 0; a < 2; ++a)
#pragma unroll
            for (int b = 0; b < 2; ++b)
#pragma unroll
                for (int m = 0; m < 4; ++m)
#pragma unroll
                    for (int n = 0; n < 2; ++n) acc[a][b][m][n] = (f32x4){0.f, 0.f, 0.f, 0.f};
        cur = nxt; cA = nA; cB = nB; ++ui;
        if constexpr (ALIGN_EPI) { if (wr == 1) PG8_BAR; }
    }
    PG8_WAIT_V(0);
    if constexpr (!ALIGN_EPI) { if (wr == 0) PG8_BAR; }
    PG8_BAR;
    if constexpr (Epi::AFTER_DRAIN) { E.fused(acc, cur, wr, wc, fr, fq, lds, wid, lane); S.done(cur); }
#undef PG8_SA
#undef PG8_SB
#undef PG8_STAGE
#undef PG8_LDA
#undef PG8_LDB
#undef PG8_MMA
#undef PG8_WAIT_V
#undef PG8_WAIT_L
#undef PG8_BAR
#undef PG8_SCHED
}
}

#define LAS __attribute__((address_space(3)))
typedef unsigned short bf16_t;
using pg8::bf16x8; using pg8::f32x4; using pg8::u32x4;
typedef unsigned u32x2 __attribute__((ext_vector_type(2)));
typedef short bf16x4 __attribute__((ext_vector_type(4)));

constexpr int NB = 4, T = 8192, D = 1024, M = NB * T, DEPTH = 4, NMEM = 256, MM = NB * NMEM;
constexpr int DIN = 2560, FF = 2816;
constexpr float EPS = 1e-6f, LOG2E = 1.4426950408889634f;
constexpr size_t MiB = 1u << 20;
constexpr size_t WS_CTL = 0, CTL_BYTES = 1 * MiB;
constexpr size_t WS_LB = 1 * MiB, WS_PART = 2 * MiB, WS_DBUF = 4 * MiB, WS_POOLT = 5 * MiB, WS_MEMN = 6 * MiB, WS_KB = 14 * MiB, WS_VTB = 22 * MiB, WS_WKV = 30 * MiB;
constexpr size_t WS_W13A = 46 * MiB, WS_W2A = 57 * MiB, WS_W13B = 63 * MiB, WS_W2B = 74 * MiB, WS_WIN = 80 * MiB, WS_WOUT = 85 * MiB, WS_WQ = 87 * MiB, WS_WO = 89 * MiB;
constexpr size_t WS_XB = 92 * MiB, WS_R1 = 156 * MiB, WS_SBUF = 332 * MiB, WS_OCAT = 396 * MiB, WS_XLO = 460 * MiB, WS_END = 492 * MiB;
constexpr int LDS_BYTES = 155648;
constexpr int NPHASE = 2 + 12 * DEPTH + (DEPTH - 1) + 1 - DEPTH;

struct Args { const float* in[23]; float* out; unsigned char* ws; int ph_lo, ph_hi; };

__device__ __forceinline__ float bf2f(unsigned b) { return __uint_as_float(b << 16); }
typedef float f32x2_t __attribute__((ext_vector_type(2))); typedef __bf16 bf16x2_t __attribute__((ext_vector_type(2)));
__device__ __forceinline__ unsigned pk2(float lo, float hi) { f32x2_t v = {lo, hi}; bf16x2_t b = __builtin_convertvector(v, bf16x2_t); return __builtin_bit_cast(unsigned, b); }
__device__ __forceinline__ float wave_sum(float v) {
#pragma unroll
    for (int o = 1; o < 64; o <<= 1) v += __shfl_xor(v, o);
    return v;
}
__device__ __forceinline__ float row_rstd(const float* part, int r) {
    const f32x4* p = (const f32x4*)(part + (size_t)r * 16);
    const f32x4 a = p[0], b = p[1], c = p[2], d = p[3];
    const float s = ((a.x + a.y) + (a.z + a.w)) + ((b.x + b.y) + (b.z + b.w)) + ((c.x + c.y) + (c.z + c.w)) + ((d.x + d.y) + (d.z + d.w));
    return rsqrtf(s * (1.f / 1024.f) + EPS);
}
#define LBAR() do { asm volatile("s_waitcnt lgkmcnt(0)" ::: "memory"); __builtin_amdgcn_s_barrier(); asm volatile("" ::: "memory"); } while (0)
__device__ __forceinline__ float silu_f(float x) { return x * __builtin_amdgcn_rcpf(1.f + __builtin_amdgcn_exp2f(-x * LOG2E)); }

__device__ __forceinline__ void rstd8(const float* part, int rowU0, int fr, int fq, float (&rs)[8]) {
    const unsigned vo = (unsigned)(fr * 16 + fq * 4);
#pragma unroll
    for (int i = 0; i < 8; ++i) { const float* pb = part + (size_t)(rowU0 + (i >> 2) * 128 + (i & 3) * 16) * 16; const f32x4 p = *(const f32x4*)(pb + vo); rs[i] = (p.x + p.y) + (p.z + p.w); }
#pragma unroll
    for (int i = 0; i < 8; ++i) { float s = rs[i]; s += __shfl_xor(s, 16); s += __shfl_xor(s, 32); rs[i] = rsqrtf(s * (1.f / 1024.f) + EPS); }
}
__device__ __forceinline__ void rs_cached(const float* part, LAS unsigned char* L, int rowU0, int wr, int wc, int fr, int fq, bool fresh, float (&rs)[8]) {
    LAS f32x4* slot = (LAS f32x4*)(L + 131072) + (((wr * 4 + wc) * 64 + fq * 16 + fr) * 2);
    if (fresh) { rstd8(part, rowU0, fr, fq, rs); slot[0] = (f32x4){rs[0], rs[1], rs[2], rs[3]}; slot[1] = (f32x4){rs[4], rs[5], rs[6], rs[7]}; }
    else { const f32x4 a = slot[0], b = slot[1]; rs[0] = a[0]; rs[1] = a[1]; rs[2] = a[2]; rs[3] = a[3]; rs[4] = b[0]; rs[5] = b[1]; rs[6] = b[2]; rs[7] = b[3]; }
}
template <bool SCALE> struct EpiScale {
    static constexpr bool PERM = true, AFTER_DRAIN = false;
    bf16_t* O; int ldc; const float* part; LAS unsigned char* L;
    struct State { int pm = -1; };
    __device__ __forceinline__ void operator()(const f32x4 (&acc)[2][2][4][2], const pg8::Unit& u, int wr, int wc, int fr, int fq, State& st) const {
        const int rowU0 = u.pm * 256 + wr * 64; const unsigned vo = (unsigned)(fr * ldc + wc * 32 + 8 * fq);
        float rs[8];
        if (SCALE) rs_cached(part, L, rowU0, wr, wc, fr, fq, st.pm != u.pm, rs);
        st.pm = u.pm;
#pragma unroll
        for (int ai = 0; ai < 2; ++ai)
#pragma unroll
            for (int m = 0; m < 4; ++m) { const float r_ = SCALE ? rs[ai * 4 + m] : 1.f;
                bf16_t* rowp = O + (size_t)(rowU0 + ai * 128 + m * 16) * ldc + u.pn * 256;
#pragma unroll
                for (int bj = 0; bj < 2; ++bj) { const f32x4 v0 = acc[ai][bj][m][0] * r_, v1 = acc[ai][bj][m][1] * r_;
                    u32x4 w; w.x = pk2(v0[0], v0[1]); w.y = pk2(v0[2], v0[3]); w.z = pk2(v1[0], v1[1]); w.w = pk2(v1[2], v1[3]);
                    *(u32x4*)(rowp + (vo + bj * 128)) = w; } }
    }
};
struct EpiSwiglu {
    static constexpr bool PERM = true, AFTER_DRAIN = false;
    bf16_t* G; const float* part; LAS unsigned char* L;
    struct State { int pm = -1; };
    __device__ __forceinline__ void operator()(const f32x4 (&acc)[2][2][4][2], const pg8::Unit& u, int wr, int wc, int fr, int fq, State& st) const {
        const int rowU0 = u.pm * 256 + wr * 64; const unsigned vo = (unsigned)(fr * FF + wc * 32 + 8 * fq);
        float rs[8];
        rs_cached(part, L, rowU0, wr, wc, fr, fq, st.pm != u.pm, rs);
        st.pm = u.pm;
#pragma unroll
        for (int ai = 0; ai < 2; ++ai)
#pragma unroll
            for (int m = 0; m < 4; ++m) { const float r_ = rs[ai * 4 + m], c_ = -r_ * LOG2E, r2_ = r_ * r_;
                f32x2_t g2[4];
#pragma unroll
                for (int n = 0; n < 2; ++n)
#pragma unroll
                    for (int jp = 0; jp < 2; ++jp) { const f32x2_t a1 = {acc[ai][0][m][n][2 * jp], acc[ai][0][m][n][2 * jp + 1]}, a3 = {acc[ai][1][m][n][2 * jp], acc[ai][1][m][n][2 * jp + 1]};
                        const f32x2_t t = a1 * c_; f32x2_t e; e.x = __builtin_amdgcn_exp2f(t.x); e.y = __builtin_amdgcn_exp2f(t.y);
                        const f32x2_t d = e + 1.f; f32x2_t q; q.x = __builtin_amdgcn_rcpf(d.x); q.y = __builtin_amdgcn_rcpf(d.y);
                        g2[n * 2 + jp] = ((a1 * a3) * r2_) * q; }
                u32x4 w; w.x = pk2(g2[0].x, g2[0].y); w.y = pk2(g2[1].x, g2[1].y); w.z = pk2(g2[2].x, g2[2].y); w.w = pk2(g2[3].x, g2[3].y);
                bf16_t* rowp = G + (size_t)(rowU0 + ai * 128 + m * 16) * FF + u.pn * 128;
                *(u32x4*)(rowp + vo) = w; }
    }
};
__device__ __forceinline__ float xs_join(unsigned hbits, unsigned nib_at_top) { return __uint_as_float(hbits + (unsigned)(((int)nib_at_top >> 28) << 12)); }
__device__ __forceinline__ unsigned xs_lo(float x, unsigned hbits) { int q = ((int)(__float_as_uint(x) - hbits) + 0x800) >> 12; q = q > 7 ? 7 : q; return (unsigned)q & 0xfu; }
struct EpiResid {
    static constexpr bool PERM = true, AFTER_DRAIN = false;
    bf16_t* XB; unsigned char* XL; float* part; float scale;
    struct State {};
    __device__ __forceinline__ void operator()(const f32x4 (&acc)[2][2][4][2], const pg8::Unit& u, int wr, int wc, int fr, int fq, State&) const {
        const int rowU0 = u.pm * 256 + wr * 64; const unsigned vo = (unsigned)(fr * D + wc * 32 + 8 * fq), vp = (unsigned)(fr * 16);
#pragma unroll
        for (int ai = 0; ai < 2; ++ai) {
            u32x4 xv[4][2]; unsigned lv[4][2];
#pragma unroll
            for (int m = 0; m < 4; ++m) { const size_t ro = (size_t)(rowU0 + ai * 128 + m * 16) * D + u.pn * 256; const bf16_t* brow = XB + ro; const unsigned char* lrow = XL + (ro >> 1);
#pragma unroll
                for (int bj = 0; bj < 2; ++bj) { xv[m][bj] = *(const u32x4*)(brow + (vo + bj * 128)); lv[m][bj] = *(const unsigned*)(lrow + ((vo + bj * 128) >> 1)); } }
#pragma unroll
            for (int m = 0; m < 4; ++m) { const size_t rU = (size_t)(rowU0 + ai * 128 + m * 16); float ss = 0.f;
                bf16_t* brow = XB + rU * D + u.pn * 256; unsigned char* lrow = XL + ((rU * D + u.pn * 256) >> 1);
#pragma unroll
                for (int bj = 0; bj < 2; ++bj) { const u32x4 xr = xv[m][bj]; const unsigned lr = lv[m][bj]; u32x4 w; unsigned lw = 0u;
#pragma unroll
                    for (int q = 0; q < 4; ++q) { const f32x4& av = acc[ai][bj][m][q >> 1];
                        const float lo = xs_join(xr[q] << 16, lr << (28 - 8 * q)) + av[(q & 1) * 2] * scale, hi = xs_join(xr[q] & 0xffff0000u, lr << (24 - 8 * q)) + av[(q & 1) * 2 + 1] * scale;
                        w[q] = pk2(lo, hi);
                        lw |= (xs_lo(lo, w[q] << 16) | (xs_lo(hi, w[q] & 0xffff0000u) << 4)) << (8 * q);
                        const float rl = bf2f(w[q] & 0xffffu), rh = __uint_as_float(w[q] & 0xffff0000u); ss += rl * rl + rh * rh; }
                    *(u32x4*)(brow + (vo + bj * 128)) = w; *(unsigned*)(lrow + ((vo + bj * 128) >> 1)) = lw; }
                ss += __shfl_xor(ss, 16); ss += __shfl_xor(ss, 32);
                float* pp = part + rU * 16 + u.pn * 4 + wc;
                if (fq == 0) pp[vp] = ss; }
            }
    }
};
struct SingleUnit { int pm, pn;
    __device__ __forceinline__ bool next(int i, pg8::Unit& u) const { if (i) return false; u.pm = pm; u.pn = pn; return true; }
    __device__ __forceinline__ void a_ready(const pg8::Unit&) const {}
    __device__ __forceinline__ void done(const pg8::Unit&) const {}
};

__device__ __forceinline__ void tr_item(const float* W, int ldw, int col0, int k0, const float* gain, float scale, bf16_t* dst, int ldd, int drow0, LAS float* scr, int lane) {
#pragma unroll 8
    for (int i = 0; i < 32; ++i) { const int kk = 2 * i + (lane >> 5); const float g = gain ? gain[k0 + kk] * scale : scale;
        scr[kk * 33 + (lane & 31)] = W[(size_t)(k0 + kk) * ldw + col0 + (lane & 31)] * g; }
    asm volatile("s_waitcnt lgkmcnt(0)" ::: "memory");
    const int c = lane & 7;
#pragma unroll
    for (int j = 0; j < 4; ++j) { const int n = (lane >> 3) + 8 * j; const LAS float* s = scr + (8 * c) * 33 + n;
        u32x4 o; o.x = pk2(s[0 * 33], s[1 * 33]); o.y = pk2(s[2 * 33], s[3 * 33]); o.z = pk2(s[4 * 33], s[5 * 33]); o.w = pk2(s[6 * 33], s[7 * 33]);
        *(u32x4*)(dst + (size_t)(drow0 + n) * ldd + k0 + 8 * c) = o; }
    asm volatile("s_waitcnt lgkmcnt(0)" ::: "memory");
}
__device__ __forceinline__ void conv_layer(const Args& a, int l, LAS float* scr, int gw, int NGW, int lane) {
    unsigned char* ws = a.ws;
    constexpr int I13 = 176 * 16, I2 = 32 * 44, IIN = 80 * 16, ISQ = 32 * 16, IPOOL = 32;
    constexpr int NIT = 2 * I13 + 2 * I2 + IIN + 3 * ISQ + IPOOL;
    for (int it = gw; it < NIT; it += NGW) {
        int r = it;
        if (r < 2 * I13) { const int second = r >= I13; if (second) r -= I13;
            const int rb = r >> 4, kb = r & 15, r0 = rb * 32, pn = r0 >> 8, within = r0 & 255;
            const float* src = (within < 128 ? a.in[second ? 19 : 3] : a.in[second ? 20 : 4]) + (size_t)l * D * FF;
            tr_item(src, FF, pn * 128 + (within & 127), kb * 64, a.in[second ? 18 : 2] + l * D, 1.f, (bf16_t*)(ws + (second ? WS_W13B : WS_W13A)), D, r0, scr, lane); continue; }
        r -= 2 * I13;
        if (r < 2 * I2) { const int second = r >= I2; if (second) r -= I2;
            const int rb = r / 44, kb = r % 44;
            tr_item(a.in[second ? 21 : 5] + (size_t)l * FF * D, D, rb * 32, kb * 64, nullptr, 1.f, (bf16_t*)(ws + (second ? WS_W2B : WS_W2A)), FF, rb * 32, scr, lane); continue; }
        r -= 2 * I2;
        if (r < IIN) { const int rb = r >> 4, kb = r & 15;
            tr_item(a.in[7] + (size_t)l * D * DIN, DIN, rb * 32, kb * 64, a.in[6] + l * D, 1.f, (bf16_t*)(ws + WS_WIN), D, rb * 32, scr, lane); continue; }
        r -= IIN;
        if (r < 3 * ISQ) { const int which = r / ISQ; r -= which * ISQ; const int rb = r >> 4, kb = r & 15;
            const float* src = a.in[which == 0 ? 12 : (which == 1 ? 15 : 17)] + (size_t)l * D * D;
            tr_item(src, D, rb * 32, kb * 64, which == 1 ? a.in[13] + l * D : nullptr, which == 1 ? 0.0625f : 1.f, (bf16_t*)(ws + (which == 0 ? WS_WOUT : (which == 1 ? WS_WQ : WS_WO))), D, rb * 32, scr, lane); continue; }
        r -= 3 * ISQ;
        { const int g = r >> 3, rr = r & 7, kb = rr & 1, rb = rr >> 1;
            tr_item(a.in[10] + (size_t)(l * 4 + g) * 128 * 128, 128, rb * 32, kb * 64, nullptr, 1.f, (bf16_t*)(ws + WS_POOLT) + g * 16384, 128, rb * 32, scr, lane); }
    }
}

__device__ __forceinline__ void p0_prologue(const Args& a, LAS unsigned char* L, int vcu, int G, int tid, int wave, int lane) {
    unsigned char* ws = a.ws;
    const int gw = vcu * 8 + wave, NGW = G * 8;
    LAS float* scr = (LAS float*)(L + wave * 16384);
    { const float* x = a.in[0]; bf16_t* XB = (bf16_t*)(ws + WS_XB); float* part = (float*)(ws + WS_PART);
      for (int m = gw; m < M; m += NGW) {
          const f32x4* xr = (const f32x4*)(x + (size_t)m * D) + lane;
          unsigned long long* o8 = (unsigned long long*)(XB + (size_t)m * D) + lane; unsigned short* l4 = (unsigned short*)(ws + WS_XLO + (size_t)m * (D / 2)) + lane;
          float s = 0.f;
#pragma unroll
          for (int j = 0; j < 4; ++j) { const f32x4 v = xr[64 * j]; const unsigned w0 = pk2(v.x, v.y), w1 = pk2(v.z, v.w);
              const float r0 = bf2f(w0 & 0xffffu), r1 = __uint_as_float(w0 & 0xffff0000u), r2 = bf2f(w1 & 0xffffu), r3 = __uint_as_float(w1 & 0xffff0000u); s += (r0 * r0 + r1 * r1) + (r2 * r2 + r3 * r3);
              o8[64 * j] = (unsigned long long)w0 | ((unsigned long long)w1 << 32);
              l4[64 * j] = (unsigned short)(xs_lo(v.x, w0 << 16) | (xs_lo(v.y, w0 & 0xffff0000u) << 4) | (xs_lo(v.z, w1 << 16) << 8) | (xs_lo(v.w, w1 & 0xffff0000u) << 12)); }
          s = wave_sum(s);
          if (lane < 16) part[(size_t)m * 16 + lane] = lane == 0 ? s : 0.f;
      } }
    { const float* mem = a.in[1]; bf16_t* MN = (bf16_t*)(ws + WS_MEMN);
      for (int m = gw; m < MM; m += NGW) {
          const f32x4* xr = (const f32x4*)(mem + (size_t)m * D) + lane; f32x4 v[4]; float s = 0.f;
#pragma unroll
          for (int j = 0; j < 4; ++j) { v[j] = xr[64 * j]; s += (v[j].x * v[j].x + v[j].y * v[j].y) + (v[j].z * v[j].z + v[j].w * v[j].w); }
          const float rs = rsqrtf(wave_sum(s) * (1.f / 1024.f) + EPS);
          for (int l = 0; l < DEPTH; ++l) { const f32x4* g = (const f32x4*)(a.in[14] + l * D) + lane;
              unsigned long long* o8 = (unsigned long long*)(MN + ((size_t)l * MM + m) * D) + lane;
#pragma unroll
              for (int j = 0; j < 4; ++j) { const f32x4 gg = g[64 * j]; const f32x4 y = v[j] * rs * gg;
                  o8[64 * j] = (unsigned long long)pk2(y.x, y.y) | ((unsigned long long)pk2(y.z, y.w) << 32); } }
      } }
    if (vcu == 0) { float* LB = (float*)(ws + WS_LB); const float* lg = a.in[8];
        const float e0 = lg[tid], e1 = lg[512 + tid], e2 = lg[1024 + tid], e3 = lg[1536 + tid];
        const float mx = fmaxf(fmaxf(e0, e1), fmaxf(e2, e3));
        const float p0 = __expf(e0 - mx), p1 = __expf(e1 - mx), p2 = __expf(e2 - mx), p3 = __expf(e3 - mx), inv = 1.f / (p0 + p1 + p2 + p3);
        LB[tid] = 0.f; LB[512 + tid] = p1 * inv; LB[1024 + tid] = (p1 + p2) * inv; LB[1536 + tid] = (p1 + p2 + p3) * inv; }
    for (int it = gw; it < 4096; it += NGW) { const int l = it >> 10, rr = it & 1023, rb = rr >> 4, kb = rr & 15;
        tr_item(a.in[16] + (size_t)l * D * 2048, 2048, rb * 32, kb * 64, nullptr, 1.f, (bf16_t*)(ws + WS_WKV) + (size_t)l * 2048 * D, D, rb * 32, scr, lane); }
    conv_layer(a, 0, scr, gw, NGW, lane);
}

__device__ __forceinline__ void e_pair_load(const bf16_t* P, int u, int pu, int tid, unsigned (&zr)[16], unsigned (&vr)[16], unsigned (&ur)[20]) {
    const int col = tid & 127, sg = tid >> 7;
    const int h = u & 3, c = (u >> 2) & 127, b = u >> 9, t0 = b * T + c * 64;
    const int g = pu & 3, tile = pu >> 2, pt0 = tile * 64, tpos0 = pt0 & (T - 1);
    const bf16_t* pz = P + (size_t)(t0 + 16 * sg) * DIN + 512 + h * 128 + col;
#pragma unroll
    for (int i = 0; i < 16; ++i) { zr[i] = pz[(size_t)i * DIN]; vr[i] = pz[(size_t)i * DIN + 512]; }
    const bf16_t* pu_ = P + 2048 + g * 128 + col;
#pragma unroll
    for (int j = 0; j < 20; ++j) { const int r = sg + 4 * j, tp = tpos0 - 15 + r; ur[j] = (r < 79 && tp >= 0) ? (unsigned)pu_[(size_t)(pt0 - 15 + r) * DIN] : 0u; }
}
__device__ __forceinline__ void e_unit_pair(LAS unsigned char* L, const float* LBl, bf16_t* SB, float* DB, const bf16_t* PT, const float* pscale, bf16_t* OC,
                                            int u, int pu, int tid, int wave, int lane, const unsigned (&zr)[16], const unsigned (&vr)[16], const unsigned (&ur)[20]) {
    int col = tid & 127, sg = tid >> 7, fr = lane & 15, fq = lane >> 4;
#define E_RELANE() do { int t_ = tid; asm volatile("" : "+v"(t_)); col = t_ & 127; sg = t_ >> 7; fr = t_ & 15; fq = (t_ >> 4) & 3; } while (0)
    const int h = u & 3, c = (u >> 2) & 127, b = u >> 9, t0 = b * T + c * 64, sidx = (b * 4 + h) * 128 + c;
    LAS float* tot = (LAS float*)L;
    LAS bf16_t* kT = (LAS bf16_t*)(L + 2048);
    LAS bf16_t* vT = (LAS bf16_t*)(L + 2048 + 128 * 144);
    const int g = pu & 3, tile = pu >> 2, pt0 = tile * 64, tpos0 = pt0 & (T - 1);
    LAS float* uL = (LAS float*)(L + 40960);
    LAS bf16_t* pL = (LAS bf16_t*)(L + 40960 + 79 * 128 * 4);
    const float lb = LBl[h * 128 + col], oml = 1.f - lb;
    float kk[16], cs[16]; float run = 0.f;
#pragma unroll
    for (int i = 0; i < 16; ++i) { float z = bf2f(zr[i]); z = fminf(fmaxf(z, -30.f), 30.f);
        const float sig = __builtin_amdgcn_rcpf(1.f + __builtin_amdgcn_exp2f(-z * LOG2E)), f = lb + oml * sig;
        run += __builtin_amdgcn_logf(f); cs[i] = run; kk[i] = 1.f - f; }
    tot[sg * 128 + col] = run;
#pragma unroll
    for (int j = 0; j < 20; ++j) { const int r = sg + 4 * j; if (r < 79) uL[r * 128 + col] = bf2f(ur[j]); }
    LBAR(); E_RELANE();
    { float pre = 0.f, btot = 0.f;
#pragma unroll
      for (int j = 0; j < 4; ++j) { const float tj = tot[j * 128 + col]; btot += tj; if (j < sg) pre += tj; }
      unsigned wk[8], wv[8];
#pragma unroll
      for (int i = 0; i < 8; ++i) { const float e0 = __builtin_amdgcn_exp2f(btot - (pre + cs[2 * i])), e1 = __builtin_amdgcn_exp2f(btot - (pre + cs[2 * i + 1]));
          wk[i] = pk2(kk[2 * i] * e0, kk[2 * i + 1] * e1); wv[i] = vr[2 * i] | (vr[2 * i + 1] << 16); }
      *(LAS u32x4*)(kT + col * 72 + 16 * sg) = (u32x4){wk[0], wk[1], wk[2], wk[3]}; *(LAS u32x4*)(kT + col * 72 + 16 * sg + 8) = (u32x4){wk[4], wk[5], wk[6], wk[7]};
      *(LAS u32x4*)(vT + col * 72 + 16 * sg) = (u32x4){wv[0], wv[1], wv[2], wv[3]}; *(LAS u32x4*)(vT + col * 72 + 16 * sg + 8) = (u32x4){wv[4], wv[5], wv[6], wv[7]};
      if (sg == 0) DB[(size_t)sidx * 128 + col] = __builtin_amdgcn_exp2f(btot); }
    { const int w = 2 << g, s0 = 16 * sg; float sum = 0.f;
      for (int j = 1; j < w; ++j) sum += uL[(15 + s0 - j) * 128 + col];
#pragma unroll
      for (int i = 0; i < 16; ++i) { const int s = s0 + i; const float cur = uL[(15 + s) * 128 + col]; sum += cur;
          const int cnt = min(tpos0 + s + 1, w);
          const float p = sum * __builtin_amdgcn_rcpf((float)cnt) - cur;
          pL[s * 136 + col] = (bf16_t)(pk2(p, 0.f) & 0xffffu);
          sum -= uL[(16 + s - w) * 128 + col]; } }
    LBAR(); E_RELANE();
    const int tb = wave >> 1, dh = wave & 1;
    const bf16_t* wt = PT + g * 16384;
    bf16x8 wfr[4][4]; f32x4 scv[4];
#pragma unroll
    for (int nt = 0; nt < 4; ++nt) { const int d0 = 64 * dh + 16 * nt;
#pragma unroll
        for (int k = 0; k < 4; ++k) wfr[nt][k] = *(const bf16x8*)(wt + (d0 + fr) * 128 + 32 * k + 8 * fq);
        scv[nt] = *(const f32x4*)(pscale + g * 128 + d0 + 4 * fq); }
    { const bf16x8 a0 = *(const LAS bf16x8*)(kT + (16 * wave + fr) * 72 + 8 * fq), a1 = *(const LAS bf16x8*)(kT + (16 * wave + fr) * 72 + 32 + 8 * fq);
      bf16_t* ut = SB + (size_t)sidx * 16384;
#pragma unroll
      for (int nt = 0; nt < 8; ++nt) {
          const bf16x8 b0 = *(const LAS bf16x8*)(vT + (16 * nt + fr) * 72 + 8 * fq), b1 = *(const LAS bf16x8*)(vT + (16 * nt + fr) * 72 + 32 + 8 * fq);
          f32x4 acc = {0.f, 0.f, 0.f, 0.f};
          acc = __builtin_amdgcn_mfma_f32_16x16x32_bf16(a0, b0, acc, 0, 0, 0);
          acc = __builtin_amdgcn_mfma_f32_16x16x32_bf16(a1, b1, acc, 0, 0, 0);
          *(u32x2*)(ut + (16 * nt + fr) * 128 + 16 * wave + 4 * fq) = (u32x2){pk2(acc[0], acc[1]), pk2(acc[2], acc[3])};
      } }
    { bf16x8 pf[4];
#pragma unroll
      for (int k = 0; k < 4; ++k) pf[k] = *(const LAS bf16x8*)(pL + (16 * tb + fr) * 136 + 32 * k + 8 * fq);
#pragma unroll
      for (int nt = 0; nt < 4; ++nt) { const int d0 = 64 * dh + 16 * nt; f32x4 acc = {0.f, 0.f, 0.f, 0.f};
#pragma unroll
          for (int k = 0; k < 4; ++k) acc = __builtin_amdgcn_mfma_f32_16x16x32_bf16(wfr[nt][k], pf[k], acc, 0, 0, 0);
          const f32x4 sc = scv[nt];
          *(u32x2*)(OC + (size_t)(pt0 + 16 * tb + fr) * D + 512 + g * 128 + d0 + 4 * fq) = (u32x2){pk2(acc[0] * sc[0], acc[1] * sc[1]), pk2(acc[2] * sc[2], acc[3] * sc[3])};
      } }
}
#undef E_RELANE

__device__ __forceinline__ void hgrn_scan(bf16_t* SB, const float* DB, int vcu, int G, int tid) {
    for (int e = vcu * 512 + tid; e < 16 * 8192; e += G * 512) {
        const int bh = e >> 13, pi = e & 8191;
        unsigned* sp = (unsigned*)(SB + (size_t)bh * 128 * 16384) + pi;
        const float* dp = DB + (size_t)bh * 128 * 128 + 2 * (pi & 63);
        float s0 = 0.f, s1 = 0.f;
        for (int c0 = 0; c0 < 128; c0 += 16) {
            unsigned uu[16]; float d0[16], d1[16];
#pragma unroll
            for (int i = 0; i < 16; ++i) { uu[i] = sp[(size_t)(c0 + i) * 8192]; const float2 dd = *(const float2*)(dp + (c0 + i) * 128); d0[i] = dd.x; d1[i] = dd.y; }
#pragma unroll
            for (int i = 0; i < 16; ++i) { sp[(size_t)(c0 + i) * 8192] = pk2(s0, s1);
                s0 = d0[i] * s0 + bf2f(uu[i] & 0xffffu); s1 = d1[i] * s1 + __uint_as_float(uu[i] & 0xffff0000u); }
        }
    }
}

constexpr int HOUT_LDS = 75776;
__device__ __forceinline__ void hgrn_out_pair(LAS unsigned char* L0, const bf16_t* P, const float* LBl, const bf16_t* SB, const float* hg, bf16_t* OC, int uA, int uB, int tid, int wave, int lane) {
    int col = tid & 127, sg = tid >> 7, fr = lane & 15, fq = lane >> 4; const int tb = wave >> 1, vh = wave & 1, sb = wave & 1;
#define HOUT_RELANE() do { int t_ = tid; asm volatile("" : "+v"(t_)); col = t_ & 127; sg = t_ >> 7; fr = t_ & 15; fq = (t_ >> 4) & 3; } while (0)
    int h[2], t0[2], sidx[2];
    float kk[2][16], cs[2][16], qv[2][16]; unsigned vr[2][16];
#pragma unroll
    for (int p = 0; p < 2; ++p) { const int u = p ? uB : uA; h[p] = u & 3; const int c = (u >> 2) & 127, b = u >> 9; t0[p] = b * T + c * 64; sidx[p] = (b * 4 + h[p]) * 128 + c; }
    unsigned qr[2][16], zr[2][16];
#pragma unroll
    for (int p = 0; p < 2; ++p) { const bf16_t* pq = P + (size_t)(t0[p] + 16 * sg) * DIN + h[p] * 128 + col;
#pragma unroll
        for (int i = 0; i < 16; ++i) { qr[p][i] = pq[(size_t)i * DIN]; zr[p][i] = pq[(size_t)i * DIN + 512]; vr[p][i] = pq[(size_t)i * DIN + 1024]; } }
#pragma unroll
    for (int p = 0; p < 2; ++p) { LAS float* tot = (LAS float*)(L0 + p * HOUT_LDS);
        const float lb = LBl[h[p] * 128 + col], oml = 1.f - lb; float run = 0.f;
#pragma unroll
        for (int i = 0; i < 16; ++i) { float z = bf2f(zr[p][i]); z = fminf(fmaxf(z, -30.f), 30.f);
            const float sig = __builtin_amdgcn_rcpf(1.f + __builtin_amdgcn_exp2f(-z * LOG2E)), f = lb + oml * sig;
            run += __builtin_amdgcn_logf(f); cs[p][i] = run; kk[p][i] = 1.f - f; qv[p][i] = bf2f(qr[p][i]); }
        tot[sg * 128 + col] = run; }
    LBAR(); HOUT_RELANE();
#pragma unroll
    for (int p = 0; p < 2; ++p) { LAS unsigned char* L = L0 + p * HOUT_LDS;
        LAS float* tot = (LAS float*)L; LAS bf16_t* qh = (LAS bf16_t*)(L + 4096); LAS bf16_t* k0L = (LAS bf16_t*)(L + 4096 + 17408); LAS bf16_t* q1L = (LAS bf16_t*)(L + 4096 + 26112);
        LAS bf16_t* k1L = (LAS bf16_t*)(L + 4096 + 34816); LAS bf16_t* vT = (LAS bf16_t*)(L + 4096 + 43520);
        float pre = 0.f;
#pragma unroll
        for (int j = 0; j < 4; ++j) { const float tj = tot[j * 128 + col]; if (j < sg) pre += tj; }
        const float b31 = tot[col] + tot[128 + col];
#pragma unroll
        for (int i = 0; i < 16; ++i) { const int s = 16 * sg + i; const float bb = pre + cs[p][i];
            qh[s * 136 + col] = (bf16_t)(pk2(qv[p][i] * __builtin_amdgcn_exp2f(bb), 0.f) & 0xffffu);
            if (sg < 2) { k0L[s * 136 + col] = (bf16_t)(pk2(kk[p][i] * __builtin_amdgcn_exp2f(fminf(-bb, 115.f)), 0.f) & 0xffffu); }
            else { q1L[(s - 32) * 136 + col] = (bf16_t)(pk2(qv[p][i] * __builtin_amdgcn_exp2f(bb - b31), 0.f) & 0xffffu);
                   k1L[(s - 32) * 136 + col] = (bf16_t)(pk2(kk[p][i] * __builtin_amdgcn_exp2f(fminf(b31 - bb, 115.f)), 0.f) & 0xffffu); } }
        unsigned wv[8];
#pragma unroll
        for (int i = 0; i < 8; ++i) wv[i] = vr[p][2 * i] | (vr[p][2 * i + 1] << 16);
        *(LAS u32x4*)(vT + col * 72 + 16 * sg) = (u32x4){wv[0], wv[1], wv[2], wv[3]}; *(LAS u32x4*)(vT + col * 72 + 16 * sg + 8) = (u32x4){wv[4], wv[5], wv[6], wv[7]}; }
    HOUT_RELANE();
    bf16x8 sfr[2][4][4];
#pragma unroll
    for (int p = 0; p < 2; ++p) { const bf16_t* st = SB + (size_t)sidx[p] * 16384;
#pragma unroll
        for (int nt = 0; nt < 4; ++nt)
#pragma unroll
            for (int k = 0; k < 4; ++k) sfr[p][nt][k] = *(const bf16x8*)(st + (64 * vh + 16 * nt + fr) * 128 + 32 * k + 8 * fq); }
    LBAR(); HOUT_RELANE();
#pragma unroll
    for (int p = 0; p < 2; ++p) { LAS unsigned char* L = L0 + p * HOUT_LDS;
        LAS bf16_t* qh = (LAS bf16_t*)(L + 4096); LAS bf16_t* k0L = (LAS bf16_t*)(L + 4096 + 17408); LAS bf16_t* q1L = (LAS bf16_t*)(L + 4096 + 26112);
        LAS bf16_t* k1L = (LAS bf16_t*)(L + 4096 + 34816); LAS bf16_t* aL = (LAS bf16_t*)(L + 4096 + 61952);
        f32x4 acc = {0.f, 0.f, 0.f, 0.f};
#pragma unroll
        for (int k = 0; k < 4; ++k) { const bf16x8 kf = *(const LAS bf16x8*)(k0L + (16 * sb + fr) * 136 + 32 * k + 8 * fq), qf = *(const LAS bf16x8*)(qh + (16 * tb + fr) * 136 + 32 * k + 8 * fq);
            acc = __builtin_amdgcn_mfma_f32_16x16x32_bf16(kf, qf, acc, 0, 0, 0); }
        const int t = 16 * tb + fr, s0 = 16 * sb + 4 * fq;
#pragma unroll
        for (int j = 0; j < 4; ++j) if (s0 + j > t) acc[j] = 0.f;
        *(LAS u32x2*)(aL + t * 72 + s0) = (u32x2){pk2(acc[0], acc[1]), pk2(acc[2], acc[3])};
        if (wave < 4) { f32x4 ac2 = {0.f, 0.f, 0.f, 0.f};
#pragma unroll
            for (int k = 0; k < 4; ++k) { const bf16x8 kf = *(const LAS bf16x8*)(k1L + (16 * sb + fr) * 136 + 32 * k + 8 * fq), qf = *(const LAS bf16x8*)(q1L + (16 * tb + fr) * 136 + 32 * k + 8 * fq);
                ac2 = __builtin_amdgcn_mfma_f32_16x16x32_bf16(kf, qf, ac2, 0, 0, 0); }
            const int t2 = 32 + 16 * tb + fr, s2 = 32 + 16 * sb + 4 * fq;
#pragma unroll
            for (int j = 0; j < 4; ++j) if (s2 + j > t2) ac2[j] = 0.f;
            *(LAS u32x2*)(aL + t2 * 72 + s2) = (u32x2){pk2(ac2[0], ac2[1]), pk2(ac2[2], ac2[3])};
        } else { const int Lx = (wave - 4) * 64 + lane; unsigned z_; asm volatile("v_mov_b32 %0, 0" : "=v"(z_));
            *(LAS u32x2*)(aL + (Lx >> 3) * 72 + 32 + 4 * (Lx & 7)) = (u32x2){z_, z_}; } }
    LBAR(); HOUT_RELANE();
    f32x4 o[2][4]; u32x2 gbr[2][4];
#pragma unroll
    for (int p = 0; p < 2; ++p) { LAS unsigned char* L = L0 + p * HOUT_LDS;
        LAS float* ssL = (LAS float*)(L + 2048); LAS bf16_t* qh = (LAS bf16_t*)(L + 4096); LAS bf16_t* vT = (LAS bf16_t*)(L + 4096 + 43520); LAS bf16_t* aL = (LAS bf16_t*)(L + 4096 + 61952);
        bf16x8 af[2], qf[4];
#pragma unroll
        for (int k = 0; k < 2; ++k) af[k] = *(const LAS bf16x8*)(aL + (16 * tb + fr) * 72 + 32 * k + 8 * fq);
#pragma unroll
        for (int k = 0; k < 4; ++k) qf[k] = *(const LAS bf16x8*)(qh + (16 * tb + fr) * 136 + 32 * k + 8 * fq);
        float ss = 0.f;
#pragma unroll
        for (int nt = 0; nt < 4; ++nt) { const int v0 = 64 * vh + 16 * nt; f32x4 acc = {0.f, 0.f, 0.f, 0.f};
#pragma unroll
            for (int k = 0; k < 2; ++k) { const bf16x8 vf = *(const LAS bf16x8*)(vT + (v0 + fr) * 72 + 32 * k + 8 * fq); acc = __builtin_amdgcn_mfma_f32_16x16x32_bf16(vf, af[k], acc, 0, 0, 0); }
#pragma unroll
            for (int k = 0; k < 4; ++k) acc = __builtin_amdgcn_mfma_f32_16x16x32_bf16(sfr[p][nt][k], qf[k], acc, 0, 0, 0);
            o[p][nt] = acc; ss += (acc[0] * acc[0] + acc[1] * acc[1]) + (acc[2] * acc[2] + acc[3] * acc[3]); }
        ss += __shfl_xor(ss, 16); ss += __shfl_xor(ss, 32);
        if (fq == 0) ssL[(16 * tb + fr) * 2 + vh] = ss; }
#pragma unroll
    for (int p = 0; p < 2; ++p) { const size_t tok = (size_t)(t0[p] + 16 * tb + fr);
#pragma unroll
        for (int nt = 0; nt < 4; ++nt) gbr[p][nt] = *(const u32x2*)(P + tok * DIN + 1536 + h[p] * 128 + 64 * vh + 16 * nt + 4 * fq); }
    LBAR(); HOUT_RELANE();
#pragma unroll
    for (int p = 0; p < 2; ++p) { LAS float* ssL = (LAS float*)(L0 + p * HOUT_LDS + 2048);
        const float rinv = rsqrtf((ssL[(16 * tb + fr) * 2] + ssL[(16 * tb + fr) * 2 + 1]) * (1.f / 128.f) + EPS);
        const size_t tok = (size_t)(t0[p] + 16 * tb + fr);
#pragma unroll
        for (int nt = 0; nt < 4; ++nt) { const int v0 = 64 * vh + 16 * nt + 4 * fq;
            const u32x2 gb = gbr[p][nt]; const f32x4 hgv = *(const f32x4*)(hg + h[p] * 128 + v0);
            const float g0 = silu_f(bf2f(gb.x & 0xffffu)), g1 = silu_f(__uint_as_float(gb.x & 0xffff0000u)), g2 = silu_f(bf2f(gb.y & 0xffffu)), g3 = silu_f(__uint_as_float(gb.y & 0xffff0000u));
            *(u32x2*)(OC + tok * D + h[p] * 128 + v0) = (u32x2){pk2(o[p][nt][0] * rinv * hgv[0] * g0, o[p][nt][1] * rinv * hgv[1] * g1), pk2(o[p][nt][2] * rinv * hgv[2] * g2, o[p][nt][3] * rinv * hgv[3] * g3)}; } }
}
#undef HOUT_RELANE

typedef float f32x16 __attribute__((ext_vector_type(16)));
#define MFMA32(a, b, c) __builtin_amdgcn_mfma_f32_32x32x16_bf16((a), (b), (c), 0, 0, 0)
__device__ __forceinline__ void attn_unit(LAS unsigned char* L, const bf16_t* Q, const bf16_t* Kl, const bf16_t* VTl, bf16_t* AO, int unit, int tid, int wave, int lane) {
    const int bh = unit >> 5, qb = unit & 31, b = bh >> 2, h = bh & 3, r = lane & 31, hh = lane >> 5;
    LAS bf16_t* kL = (LAS bf16_t*)L;
    const int frow = tid >> 1, fhalf = tid & 1;
    { const u32x4* src = (const u32x4*)(Kl + (size_t)(b * 256 + frow) * D + h * 256 + fhalf * 128); u32x4 t[16];
#pragma unroll
      for (int i = 0; i < 16; ++i) t[i] = src[i];
#pragma unroll
      for (int i = 0; i < 16; ++i) *(LAS u32x4*)(kL + frow * 264 + fhalf * 128 + 8 * i) = t[i]; }
    const size_t q0 = (size_t)b * T + (size_t)qb * 256 + 32 * wave;
    bf16x8 qf[16];
#pragma unroll
    for (int ks = 0; ks < 16; ++ks) qf[ks] = *(const bf16x8*)(Q + (q0 + r) * D + h * 256 + 16 * ks + 8 * hh);
    LBAR();
    bf16x8 pA[8], pB[8]; float mA, lA, mB, lB;
#define ATTN_S_HALF(KT0, PF, MX, LS) { f32x16 sacc[4]; \
        _Pragma("unroll") for (int t = 0; t < 4; ++t) _Pragma("unroll") for (int i = 0; i < 16; ++i) sacc[t][i] = 0.f; \
        _Pragma("unroll") for (int ks = 0; ks < 16; ++ks) _Pragma("unroll") for (int t = 0; t < 4; ++t) { \
            const bf16x8 kf = *(const LAS bf16x8*)(kL + (32 * ((KT0) + t) + r) * 264 + 16 * ks + 8 * hh); sacc[t] = MFMA32(kf, qf[ks], sacc[t]); if (t == 3) __builtin_amdgcn_sched_barrier(0); } \
        float mx_ = -3.0e38f; \
        _Pragma("unroll") for (int t = 0; t < 4; ++t) _Pragma("unroll") for (int i = 0; i < 16; ++i) mx_ = fmaxf(mx_, sacc[t][i]); \
        mx_ = fmaxf(mx_, __shfl_xor(mx_, 32)); const float mb_ = mx_ * LOG2E; float ls_ = 0.f; \
        _Pragma("unroll") for (int t = 0; t < 4; ++t) _Pragma("unroll") for (int i = 0; i < 16; ++i) { const float p_ = __builtin_amdgcn_exp2f(sacc[t][i] * LOG2E - mb_); sacc[t][i] = p_; ls_ += p_; } \
        ls_ += __shfl_xor(ls_, 32); MX = mx_; LS = ls_; \
        _Pragma("unroll") for (int t = 0; t < 4; ++t) _Pragma("unroll") for (int s = 0; s < 2; ++s) { \
            const u32x4 w_ = {pk2(sacc[t][8 * s], sacc[t][8 * s + 1]), pk2(sacc[t][8 * s + 2], sacc[t][8 * s + 3]), pk2(sacc[t][8 * s + 4], sacc[t][8 * s + 5]), pk2(sacc[t][8 * s + 6], sacc[t][8 * s + 7])}; \
            PF[t * 2 + s] = __builtin_bit_cast(bf16x8, w_); } }
    ATTN_S_HALF(0, pA, mA, lA)
    ATTN_S_HALF(4, pB, mB, lB)
#undef ATTN_S_HALF
    const float mm = fmaxf(mA, mB), eA = __builtin_amdgcn_exp2f((mA - mm) * LOG2E), eB = __builtin_amdgcn_exp2f((mB - mm) * LOG2E);
    const float linv = 1.f / (lA * eA + lB * eB), cA = eA * linv, cB = eB * linv;
    LBAR();
    { const u32x4* src = (const u32x4*)(VTl + (size_t)(h * 256 + frow) * MM + b * 256 + fhalf * 128); u32x4 t[16];
#pragma unroll
      for (int i = 0; i < 16; ++i) t[i] = src[i];
#pragma unroll
      for (int i = 0; i < 16; ++i) { LAS bf16_t* d = kL + frow * 264 + fhalf * 128 + 16 * (i >> 1) + ((i & 1) ? 4 : 0);
          *(LAS u32x2*)d = (u32x2){t[i].x, t[i].y}; *(LAS u32x2*)(d + 8) = (u32x2){t[i].z, t[i].w}; } }
    LBAR();
    bf16_t* orow = AO + (q0 + r) * D + h * 256 + 4 * hh;
#pragma unroll 2
    for (int dt = 0; dt < 8; ++dt) { f32x16 oa, ob;
#pragma unroll
        for (int i = 0; i < 16; ++i) { oa[i] = 0.f; ob[i] = 0.f; }
        const LAS bf16_t* vrow = kL + (32 * dt + r) * 264 + 8 * hh;
#pragma unroll
        for (int k = 0; k < 8; ++k) { const bf16x8 va = *(const LAS bf16x8*)(vrow + 16 * k), vb = *(const LAS bf16x8*)(vrow + 128 + 16 * k);
            oa = MFMA32(va, pA[k], oa); ob = MFMA32(vb, pB[k], ob); if (k & 1) __builtin_amdgcn_sched_barrier(0); }
#pragma unroll
        for (int g = 0; g < 4; ++g) { const float o0 = oa[4 * g] * cA + ob[4 * g] * cB, o1 = oa[4 * g + 1] * cA + ob[4 * g + 1] * cB, o2 = oa[4 * g + 2] * cA + ob[4 * g + 2] * cB, o3 = oa[4 * g + 3] * cA + ob[4 * g + 3] * cB;
            *(u32x2*)(orow + 32 * dt + 8 * g) = (u32x2){pk2(o0, o1), pk2(o2, o3)}; }
    }
    LBAR();
}

#define RLX_AGENT __ATOMIC_RELAXED, __HIP_MEMORY_SCOPE_AGENT
#define XB_TMO      128
#define XB_XCNT(j)  (256  + 64 * (j))
#define XB_XSUB(j)  (1280 + 64 * (j))
#define XB_XGEN(j)  (2304 + 64 * (j))
#define XB_TOP      3328
#define XB_TOPGEN   3392
#define XCD_BAR_WORDS 3456
#define XB_SPIN_CAP (1u << 18)

__device__ __forceinline__ unsigned xb_ld(unsigned* p)              { return __hip_atomic_load(p, __ATOMIC_RELAXED, __HIP_MEMORY_SCOPE_AGENT); }
__device__ __forceinline__ unsigned xb_add(unsigned* p, unsigned v) { return __hip_atomic_fetch_add(p, v, __ATOMIC_RELAXED, __HIP_MEMORY_SCOPE_AGENT); }
__device__ __forceinline__ unsigned xb_xcc_id() { return (unsigned)__builtin_amdgcn_s_getreg((3 << 11) | 20) & 0xFu; }
#define XB_SPIN(cond, bar) do { unsigned _sp = 0; while (cond) { __builtin_amdgcn_s_sleep(1); \
    if ((++_sp & 255u) == 0u) { if (xb_ld(&(bar)[XB_TMO])) break; if (_sp > XB_SPIN_CAP) { atomicAdd(&(bar)[XB_TMO], 1u); break; } } } } while (0)

struct XcdBarrier {
    unsigned* bar; unsigned x;
    volatile LAS unsigned* st;
};

__device__ __forceinline__ XcdBarrier xcd_barrier_post(unsigned* bar, volatile LAS unsigned* st) {
    XcdBarrier b; b.bar = bar; b.x = xb_xcc_id(); b.st = st;
    if (threadIdx.x == 0) (void)xb_add(&bar[XB_XCNT(b.x)], 1u);
    return b;
}
__device__ __forceinline__ void xcd_barrier_complete(unsigned* bar, unsigned x, unsigned& nloc, unsigned& nx) {
    const unsigned G = gridDim.x * gridDim.y * gridDim.z;
    unsigned sum, cnt, mine, sp = 0u;
    for (;;) {
        sum = 0u; cnt = 0u; mine = 0u;
#pragma unroll
        for (unsigned j = 0; j < 16; ++j) { const unsigned c = xb_ld(&bar[XB_XCNT(j)]); sum += c; cnt += (c > 0u) ? 1u : 0u; mine = (j == x) ? c : mine; }
        if (sum == G) break;
        __builtin_amdgcn_s_sleep(1);
        if ((++sp & 255u) == 0u) { if (xb_ld(&bar[XB_TMO])) break; if (sp > XB_SPIN_CAP) { atomicAdd(&bar[XB_TMO], 1u); break; } }
    }
    nloc = mine > 0u ? mine : 1u; nx = cnt > 0u ? cnt : 1u;
}

__device__ __forceinline__ void xcd_barrier(const XcdBarrier& b) {
    asm volatile("s_waitcnt vmcnt(0)" ::: "memory");
    __syncthreads();
    if (threadIdx.x == 0) {
        unsigned* bar = b.bar;
        __builtin_amdgcn_s_waitcnt(0);
        unsigned nloc = b.st[0], nx = b.st[1];
        if (nloc == 0u) { xcd_barrier_complete(bar, b.x, nloc, nx); b.st[0] = nloc; b.st[1] = nx; }
        const unsigned old = xb_add(&bar[XB_XSUB(b.x)], 1u);
        const unsigned gen = old / nloc;
        if (old + 1u == (gen + 1u) * nloc) {
            __builtin_amdgcn_fence(__ATOMIC_RELEASE, "agent");
            asm volatile("s_waitcnt vmcnt(0)" ::: "memory");
            const unsigned og = xb_add(&bar[XB_TOP], 1u);
            const unsigned tg = og / nx;
            if (og + 1u == (tg + 1u) * nx) xb_add(&bar[XB_TOPGEN], 1u);
            else XB_SPIN(xb_ld(&bar[XB_TOPGEN]) == tg, bar);
            __builtin_amdgcn_fence(__ATOMIC_ACQUIRE, "agent");
            xb_add(&bar[XB_XGEN(b.x)], 1u);
            asm volatile("s_waitcnt vmcnt(0)" ::: "memory");
        } else {
            XB_SPIN(xb_ld(&bar[XB_XGEN(b.x)]) == gen, bar);
            __builtin_amdgcn_fence(__ATOMIC_ACQUIRE, "agent");
            asm volatile("s_waitcnt vmcnt(0)" ::: "memory");
        }
    }
    __syncthreads();
}

__global__ void __launch_bounds__(512, 2) hymba_fwd(Args a) {
    extern __shared__ __attribute__((aligned(16))) unsigned char lds_raw[];
    LAS unsigned char* L = (LAS unsigned char*)lds_raw;
    const int G = gridDim.x, bx = blockIdx.x, vcu = (G % 8 == 0) ? (bx % 8) * (G / 8) + bx / 8 : bx;
    const int NGW = G * 8;
    unsigned char* ws = a.ws;
    const int lo = a.ph_lo, hi = a.ph_hi;
    int pc = 0;
    volatile LAS unsigned* MISC = (volatile LAS unsigned*)(L + LDS_BYTES - 64);
    if (threadIdx.x < 16) MISC[threadIdx.x] = 0u;
    __syncthreads();
    const XcdBarrier bar = xcd_barrier_post((unsigned*)(a.ws + WS_CTL), MISC);
#define GRID_BAR() do { if (pc == 1) cg::this_grid().sync(); else xcd_barrier(bar); } while (0)
#define PH_BEGIN if (pc >= lo && pc < hi) { int tid = threadIdx.x; asm volatile("" : "+v"(tid)); const int lane = tid & 63, wave = __builtin_amdgcn_readfirstlane(tid >> 6), gw = vcu * 8 + wave; (void)lane; (void)gw;
#define PH_END } { ++pc; if (pc > lo && pc < hi) GRID_BAR(); }
#define GEMM_STATIC(EPI, Aptr, Btptr, Mv, Nv, Kv, Eobj) do { pg8::Gemm g_{(const bf16_t*)(Aptr), (const bf16_t*)(Btptr), Mv, Nv, Kv}; pg8::StaticOrder S_; S_.init(Mv, Nv, G, bx); \
        pg8::gemm_phase<EPI, pg8::StaticOrder, true, true>(L, g_, S_, Eobj); } while (0)

    PH_BEGIN p0_prologue(a, L, vcu, G, tid, wave, lane); PH_END
    PH_BEGIN
        for (int it = bx; it < 128; it += G) { const int gi = it >> 4, tile = it & 15, l = gi >> 1, isv = gi & 1;
            const bf16_t* mn = (const bf16_t*)(ws + WS_MEMN) + (size_t)l * MM * D; const bf16_t* wkv = (const bf16_t*)(ws + WS_WKV) + (size_t)l * 2048 * D;
            pg8::Gemm g_{isv ? wkv + (size_t)1024 * D : mn, isv ? mn : wkv, 1024, 1024, 1024};
            SingleUnit S_{tile >> 2, tile & 3};
            EpiScale<false> E_{(bf16_t*)(ws + (isv ? WS_VTB : WS_KB)) + (size_t)l * MM * D, 1024, nullptr, L};
            pg8::gemm_phase<EpiScale<false>, SingleUnit, false, true>(L, g_, S_, E_); }
    PH_END
    for (int l = 0; l < DEPTH; ++l) {
        size_t zoff = 0; int bx = blockIdx.x;
        asm volatile("" : "+s"(zoff), "+s"(bx));
        unsigned char* ws = a.ws + zoff;
        bf16_t* XB = (bf16_t*)(ws + WS_XB); float* PART = (float*)(ws + WS_PART);
        bf16_t* R1 = (bf16_t*)(ws + WS_R1); bf16_t* SB = (bf16_t*)(ws + WS_SBUF); bf16_t* OC = (bf16_t*)(ws + WS_OCAT); float* DB = (float*)(ws + WS_DBUF);
        if (l > 0) { PH_BEGIN conv_layer(a, l, (LAS float*)(L + wave * 16384), gw, NGW, lane); PH_END }
        PH_BEGIN { EpiSwiglu E_{R1, PART, L}; GEMM_STATIC(EpiSwiglu, XB, ws + WS_W13A, M, 2 * FF, D, E_); } PH_END
        PH_BEGIN { EpiResid E_{XB, ws + WS_XLO, PART, 0.5f}; GEMM_STATIC(EpiResid, R1, ws + WS_W2A, M, D, FF, E_); } PH_END
        PH_BEGIN { EpiScale<true> E_{R1, DIN, PART, L}; GEMM_STATIC(EpiScale<true>, XB, ws + WS_WIN, M, DIN, D, E_); } PH_END
        PH_BEGIN
            if (G == 256) {
                unsigned za[16], va[16], ua[20], zb[16], vb[16], ub[20];
                e_pair_load(R1, vcu, vcu, tid, za, va, ua);
                for (int i = 0; i < 8; i += 2) {
                    { const int un = vcu + (i + 1) * 256; e_pair_load(R1, un, un, tid, zb, vb, ub); }
                    { const int u = vcu + i * 256; e_unit_pair(L, (const float*)(ws + WS_LB) + l * 512, SB, DB, (const bf16_t*)(ws + WS_POOLT), a.in[11] + l * 512, OC, u, u, tid, wave, lane, za, va, ua); LBAR(); }
                    { const int un = vcu + (i + 2 < 8 ? i + 2 : 7) * 256; e_pair_load(R1, un, un, tid, za, va, ua); }
                    { const int u = vcu + (i + 1) * 256; e_unit_pair(L, (const float*)(ws + WS_LB) + l * 512, SB, DB, (const bf16_t*)(ws + WS_POOLT), a.in[11] + l * 512, OC, u, u, tid, wave, lane, zb, vb, ub); LBAR(); }
                }
            } else for (int u = vcu; u < 2048; u += G) { unsigned za[16], va[16], ua[20];
                e_pair_load(R1, u, u, tid, za, va, ua);
                e_unit_pair(L, (const float*)(ws + WS_LB) + l * 512, SB, DB, (const bf16_t*)(ws + WS_POOLT), a.in[11] + l * 512, OC, u, u, tid, wave, lane, za, va, ua);
                LBAR(); }
        PH_END
        PH_BEGIN hgrn_scan(SB, DB, vcu, G, tid); PH_END
        PH_BEGIN
            for (int u = vcu; u < 2048; u += 2 * G) { hgrn_out_pair(L, R1, (const float*)(ws + WS_LB) + l * 512, SB, a.in[9] + l * 512, OC, u, u + G, tid, wave, lane); LBAR(); }
        PH_END
        PH_BEGIN { EpiResid E_{XB, ws + WS_XLO, PART, 1.f}; GEMM_STATIC(EpiResid, OC, ws + WS_WOUT, M, D, D, E_); } PH_END
        PH_BEGIN
            { EpiScale<true> E_{R1, D, PART, L}; GEMM_STATIC(EpiScale<true>, XB, ws + WS_WQ, M, D, D, E_); }
            asm volatile("s_waitcnt vmcnt(0)" ::: "memory"); __syncthreads(); __builtin_amdgcn_fence(__ATOMIC_ACQUIRE, "agent");
            { pg8::StaticOrder S_; S_.init(M, D, G, bx); pg8::Unit u_; int tid = threadIdx.x; asm volatile("" : "+v"(tid)); const int lane = tid & 63, wave = __builtin_amdgcn_readfirstlane(tid >> 6);
              for (int i = 0; S_.next(i, u_); ++i)
                  attn_unit(L, R1, (const bf16_t*)(ws + WS_KB) + (size_t)l * MM * D, (const bf16_t*)(ws + WS_VTB) + (size_t)l * MM * D, R1 + (size_t)M * D, (((u_.pm >> 5) * 4 + u_.pn) << 5) + (u_.pm & 31), tid, wave, lane); }
        PH_END
        PH_BEGIN { EpiResid E_{XB, ws + WS_XLO, PART, 1.f}; GEMM_STATIC(EpiResid, R1 + (size_t)M * D, ws + WS_WO, M, D, D, E_); } PH_END
        PH_BEGIN { EpiSwiglu E_{R1, PART, L}; GEMM_STATIC(EpiSwiglu, XB, ws + WS_W13B, M, 2 * FF, D, E_); } PH_END
        PH_BEGIN { EpiResid E_{XB, ws + WS_XLO, PART, 0.5f}; GEMM_STATIC(EpiResid, R1, ws + WS_W2B, M, D, FF, E_); } PH_END
    }
    PH_BEGIN
        const bf16_t* XBf = (const bf16_t*)(ws + WS_XB); const float* PART = (const float*)(ws + WS_PART);
        for (int m = gw; m < M; m += NGW) { const float rs = row_rstd(PART, m); f32x4* orow = (f32x4*)(a.out + (size_t)m * D) + lane; const f32x4* g = (const f32x4*)a.in[22] + lane;
            const u32x2* xr = (const u32x2*)(XBf + (size_t)m * D) + lane; const unsigned short* lr = (const unsigned short*)(ws + WS_XLO + (size_t)m * (D / 2)) + lane;
#pragma unroll
            for (int j = 0; j < 4; ++j) { const u32x2 w = xr[64 * j]; const unsigned q = lr[64 * j];
                const f32x4 v = {xs_join(w.x << 16, q << 28), xs_join(w.x & 0xffff0000u, q << 24), xs_join(w.y << 16, q << 20), xs_join(w.y & 0xffff0000u, q << 16)};
                orow[64 * j] = v * rs * g[64 * j]; } }
    PH_END
}

extern "C" void kernel_launch(void* const* d_in, const int* in_sizes, int n_in, void* d_out, int out_size, void* d_ws, size_t ws_size, hipStream_t stream) {
    static int grid = 0;
    if (grid == 0) {
        int dev = 0, cus = 0, per_cu = 0;
        if (n_in != 23 || ws_size < WS_END) { fprintf(stderr, "kernel_launch: unexpected n_in %d / ws %zu\n", n_in, ws_size); grid = -1; return; }
        hipGetDevice(&dev); hipDeviceGetAttribute(&cus, hipDeviceAttributeMultiprocessorCount, dev);
        if (hipFuncSetAttribute((const void*)hymba_fwd, hipFuncAttributeMaxDynamicSharedMemorySize, LDS_BYTES) != hipSuccess) { fprintf(stderr, "kernel_launch: hipFuncSetAttribute failed\n"); grid = -1; return; }
        hipOccupancyMaxActiveBlocksPerMultiprocessor(&per_cu, (const void*)hymba_fwd, 512, LDS_BYTES);
        (void)hipGetLastError();
        if (per_cu < 1) fprintf(stderr, "kernel_launch: occupancy query says %d\n", per_cu);
        grid = cus > 0 ? cus : 256;
    }
    if (grid < 0) return;
    if (hipMemsetAsync((char*)d_ws + WS_CTL, 0, 16384, stream) != hipSuccess) { fprintf(stderr, "kernel_launch: memset failed\n"); return; }
    Args a{};
    for (int i = 0; i < 23; ++i) a.in[i] = (const float*)d_in[i];
    a.out = (float*)d_out; a.ws = (unsigned char*)d_ws;
    a.ph_lo = 0; a.ph_hi = NPHASE;
    void* args[] = {&a};
    hipError_t e = hipLaunchCooperativeKernel((const void*)hymba_fwd, dim3(grid), dim3(512), args, LDS_BYTES, stream);
    if (e != hipSuccess) fprintf(stderr, "cooperative launch failed: %s (grid %d)\n", hipGetErrorString(e), grid);
}
```

```cpp
#include <hip/hip_runtime.h>
#include <hip/hip_cooperative_groups.h>
#include <cstdio>
namespace cg = cooperative_groups;
namespace pg8 {
#define PG8_LAS __attribute__((address_space(3)))
typedef unsigned short bf16_t;
typedef short bf16x8 __attribute__((ext_vector_type(8)));
typedef float f32x4 __attribute__((ext_vector_type(4)));
typedef unsigned u32x4 __attribute__((ext_vector_type(4)));
constexpr int BM = 256, BK = 64, HALF = 128, HTB = HALF * BK * 2  , STAGE_BYTES = 8 * HTB, NXCD = 8, WGM = 8;

__host__ __device__ __forceinline__ int lds_byte(int r, int c) { const int st = (r >> 4) * 2 + (c >> 5), rr = r & 15, cc = c & 31, ob = rr * 64 + cc * 2; return st * 1024 + (ob ^ (((ob >> 9) & 1) << 5)); }
__host__ __device__ __forceinline__ void stage_rc(int b, int& R, int& C) { const int st = b / 1024, sb = b % 1024, swz = sb ^ (((sb >> 9) & 1) << 5); R = (st >> 1) * 16 + swz / 64; C = (st & 1) * 32 + (swz % 64) / 2; }
__host__ __device__ __forceinline__ int perm32(int rho) { const int n = rho >> 4, i = rho & 15; return 8 * (i >> 2) + 4 * n + (i & 3); }

struct Unit { int pm, pn; };
struct Gemm { const bf16_t* A; const bf16_t* Bt; int M, N, K; };

struct StaticOrder {
    int nM, nN, nwg, G, c;
    __host__ __device__ void init(int M, int N, int G_, int c_) { nM = M / BM; nN = N / BM; nwg = nM * nN; G = G_; c = c_; }
    __host__ __device__ __forceinline__ bool next(int i, Unit& u) const {
        const int L = i * G + c; if (L >= nwg) return false;
        int wgid = (int)L; { const int q = nwg / NXCD, r = nwg % NXCD, xcd = wgid % NXCD, off = wgid / NXCD; wgid = (xcd < r ? xcd * (q + 1) : r * (q + 1) + (xcd - r) * q) + off; }
        const int nig = WGM * nN, gid = wgid / nig, fm = gid * WGM, gsz = (nM - fm) < WGM ? (nM - fm) : WGM;
        u.pm = fm + ((wgid % nig) % gsz); u.pn = (wgid % nig) / gsz; return true;
    }
    __device__ __forceinline__ void a_ready(const Unit&) const {}
    __device__ __forceinline__ void done(const Unit&) const {}
};

__device__ __forceinline__ unsigned cvt_pk_bf16(float lo, float hi) { unsigned r; asm volatile("v_cvt_pk_bf16_f32 %0, %1, %2" : "=v"(r) : "v"(lo), "v"(hi)); return r; }
template <class Epi, class Sched, bool ALIGN_EPI = false, bool SP2 = false>
__device__ __forceinline__ void gemm_phase(PG8_LAS unsigned char* lds, const Gemm g, const Sched& S, const Epi& E) {
    int tid_ = threadIdx.x; asm volatile("" : "+v"(tid_));
    const int tid = tid_, wid = __builtin_amdgcn_readfirstlane(tid >> 6), lane = tid & 63, wr = wid >> 2, wc = wid & 3, fr = lane & 15, fq = lane >> 4;
    const int K = g.K, nt = K / BK;
    unsigned voffA[2], voffB[2];
#pragma unroll
    for (int i = 0; i < 2; ++i) { int R, C; stage_rc(tid * 16 + i * 8192, R, C); const int Rb = Epi::PERM ? ((R & ~31) + perm32(R & 31)) : R;
        voffA[i] = (unsigned)(R * K + C) * 2u; voffB[i] = (unsigned)(Rb * K + C) * 2u; }
    const size_t kstep = (size_t)(BK * 2);
    const size_t hstep = (size_t)HALF * K * 2;
    const size_t tstep = 2 * hstep;
    const unsigned ldsw = (unsigned)wid * 1024u;
    const int aoff = lds_byte(wr * 64 + fr, fq * 8), boff = lds_byte(wc * 32 + fr, fq * 8);
#define PG8_SA(b, h) (((b) * 2 + (h)) * HTB)
#define PG8_SB(b, h) ((4 + (b) * 2 + (h)) * HTB)
#define PG8_STAGE(bufoff, gbase, voff) do { _Pragma("unroll") for (int _i = 0; _i < 2; ++_i) \
        __builtin_amdgcn_global_load_lds((const unsigned*)((const char*)(gbase) + (voff)[_i]), (PG8_LAS unsigned*)(lds + (bufoff) + ldsw + _i * 8192), 16, 0, 0); } while (0)
#define PG8_LDA(dst, b, h) do { _Pragma("unroll") for (int m = 0; m < 4; ++m) _Pragma("unroll") for (int k = 0; k < 2; ++k) dst[m][k] = *(const PG8_LAS bf16x8*)(lds + PG8_SA(b, h) + aoff + m * 2048 + k * 1024); } while (0)
#define PG8_LDB(dst, b, h) do { _Pragma("unroll") for (int n = 0; n < 2; ++n) _Pragma("unroll") for (int k = 0; k < 2; ++k) dst[n][k] = *(const PG8_LAS bf16x8*)(lds + PG8_SB(b, h) + boff + n * 2048 + k * 1024); } while (0)
#define PG8_MMA(ai, bj, At, Bt) do { __builtin_amdgcn_s_setprio(1); _Pragma("unroll") for (int m = 0; m < 4; ++m) _Pragma("unroll") for (int n = 0; n < 2; ++n) _Pragma("unroll") for (int k = 0; k < 2; ++k) \
        acc[ai][bj][m][n] = __builtin_amdgcn_mfma_f32_16x16x32_bf16(Bt[n][k], At[m][k], acc[ai][bj][m][n], 0, 0, 0); __builtin_amdgcn_s_setprio(0); } while (0)
#define PG8_WAIT_V(n) asm volatile("s_waitcnt vmcnt(" #n ")" ::: "memory")
#define PG8_WAIT_L(n) asm volatile("s_waitcnt lgkmcnt(" #n ")" ::: "memory")
#define PG8_BAR __builtin_amdgcn_s_barrier()
#define PG8_SCHED __builtin_amdgcn_sched_barrier(0)
    Unit cur, nxt; int ui = 0;
    if (!S.next(0, cur)) return;
    typename Epi::State est;
    f32x4 acc[2][2][4][2];
#pragma unroll
    for (int a = 0; a < 2; ++a)
#pragma unroll
        for (int b = 0; b < 2; ++b)
#pragma unroll
            for (int m = 0; m < 4; ++m)
#pragma unroll
                for (int n = 0; n < 2; ++n) acc[a][b][m][n] = (f32x4){0.f, 0.f, 0.f, 0.f};
    bf16x8 At[4][2], B0[2][2], B1[2][2];
    const char* cA = (const char*)g.A + (size_t)cur.pm * tstep; const char* cB = (const char*)g.Bt + (size_t)cur.pn * tstep;
    S.a_ready(cur);
    if constexpr (SP2) {
        PG8_STAGE(PG8_SB(0, 0), cB, voffB); PG8_STAGE(PG8_SB(0, 1), cB + hstep, voffB); PG8_STAGE(PG8_SA(0, 0), cA, voffA); PG8_STAGE(PG8_SA(0, 1), cA + hstep, voffA);
        if (wr == 1) PG8_BAR;
        PG8_WAIT_V(2); PG8_BAR;
        PG8_STAGE(PG8_SB(1, 0), cB + kstep, voffB); PG8_STAGE(PG8_SA(1, 0), cA + kstep, voffA); PG8_STAGE(PG8_SB(1, 1), cB + hstep + kstep, voffB);
        PG8_WAIT_V(6); PG8_BAR;
    } else {
        PG8_STAGE(PG8_SB(0, 0), cB, voffB); PG8_STAGE(PG8_SA(0, 0), cA, voffA); PG8_STAGE(PG8_SB(0, 1), cB + hstep, voffB); PG8_STAGE(PG8_SA(0, 1), cA + hstep, voffA);
        if (wr == 1) PG8_BAR;
        PG8_WAIT_V(4); PG8_BAR;
        PG8_STAGE(PG8_SB(1, 0), cB + kstep, voffB); PG8_STAGE(PG8_SA(1, 0), cA + kstep, voffA); PG8_STAGE(PG8_SB(1, 1), cB + hstep + kstep, voffB);
        PG8_WAIT_V(6); PG8_BAR;
    }
    for (;;) {
        const bool has_next = S.next(ui + 1, nxt);
        const char* nA = has_next ? (const char*)g.A + (size_t)nxt.pm * tstep : cA; const char* nB = has_next ? (const char*)g.Bt + (size_t)nxt.pn * tstep : cB;
        for (int t = 0; t < nt; t += 2) {
            const bool last = (t == nt - 2);
            const char* a1 = cA + (size_t)(t + 1) * kstep;
            const char* a2 = last ? nA : cA + (size_t)(t + 2) * kstep; const char* b2 = last ? nB : cB + (size_t)(t + 2) * kstep;
            const char* a3 = a2 + kstep; const char* b3 = b2 + kstep;
            if (last && has_next) S.a_ready(nxt);
            if constexpr (SP2) {
            PG8_LDB(B0, 0, 0); PG8_LDB(B1, 0, 1); PG8_SCHED; PG8_LDA(At, 0, 0); PG8_STAGE(PG8_SA(1, 1), a1 + hstep, voffA);
            PG8_WAIT_V(8); PG8_WAIT_L(0); PG8_BAR; PG8_MMA(0, 0, At, B0); PG8_MMA(0, 1, At, B1); PG8_BAR; PG8_SCHED;
            PG8_LDA(At, 0, 1); PG8_STAGE(PG8_SB(0, 0), b2, voffB); PG8_STAGE(PG8_SB(0, 1), b2 + hstep, voffB); PG8_STAGE(PG8_SA(0, 0), a2, voffA);
            PG8_WAIT_V(8); PG8_WAIT_L(0); PG8_BAR; PG8_MMA(1, 0, At, B0); PG8_MMA(1, 1, At, B1); PG8_BAR; PG8_SCHED;
            PG8_LDB(B0, 1, 0); PG8_LDB(B1, 1, 1); PG8_SCHED; PG8_LDA(At, 1, 0); PG8_STAGE(PG8_SA(0, 1), a2 + hstep, voffA);
            PG8_WAIT_V(8); PG8_WAIT_L(0); PG8_BAR; PG8_MMA(0, 0, At, B0); PG8_MMA(0, 1, At, B1); PG8_BAR; PG8_SCHED;
            PG8_LDA(At, 1, 1); PG8_STAGE(PG8_SB(1, 0), b3, voffB); PG8_STAGE(PG8_SB(1, 1), b3 + hstep, voffB); PG8_STAGE(PG8_SA(1, 0), a3, voffA);
            PG8_WAIT_V(8); PG8_WAIT_L(0); PG8_BAR; PG8_MMA(1, 0, At, B0); PG8_MMA(1, 1, At, B1); PG8_BAR; PG8_SCHED;
            } else {
            PG8_LDB(B0, 0, 0); PG8_SCHED; PG8_LDA(At, 0, 0); PG8_STAGE(PG8_SA(1, 1), a1 + hstep, voffA);
            PG8_WAIT_L(8); PG8_BAR; PG8_WAIT_L(0); PG8_MMA(0, 0, At, B0); PG8_BAR; PG8_SCHED;
            PG8_LDB(B1, 0, 1); PG8_STAGE(PG8_SB(0, 0), b2, voffB);
            PG8_BAR; PG8_WAIT_L(0); PG8_MMA(0, 1, At, B1); PG8_BAR;
            PG8_LDA(At, 0, 1); PG8_STAGE(PG8_SA(0, 0), a2, voffA);
            PG8_BAR; PG8_WAIT_L(0); PG8_MMA(1, 0, At, B0); PG8_BAR; PG8_SCHED;
            PG8_STAGE(PG8_SB(0, 1), b2 + hstep, voffB);
            PG8_WAIT_V(6); PG8_BAR; PG8_MMA(1, 1, At, B1); PG8_BAR;
            PG8_LDB(B0, 1, 0); PG8_SCHED; PG8_LDA(At, 1, 0); PG8_STAGE(PG8_SA(0, 1), a2 + hstep, voffA);
            PG8_WAIT_L(8); PG8_BAR; PG8_WAIT_L(0); PG8_MMA(0, 0, At, B0); PG8_BAR; PG8_SCHED;
            PG8_LDB(B1, 1, 1); PG8_STAGE(PG8_SB(1, 0), b3, voffB);
            PG8_BAR; PG8_WAIT_L(0); PG8_MMA(0, 1, At, B1); PG8_BAR;
            PG8_LDA(At, 1, 1); PG8_STAGE(PG8_SA(1, 0), a3, voffA);
            PG8_BAR; PG8_WAIT_L(0); PG8_MMA(1, 0, At, B0); PG8_BAR; PG8_SCHED;
            PG8_STAGE(PG8_SB(1, 1), b3 + hstep, voffB);
            PG8_WAIT_V(6); PG8_BAR; PG8_MMA(1, 1, At, B1); PG8_BAR;
            }
        }
        if constexpr (ALIGN_EPI) { if (wr == 0) PG8_BAR; }
        if constexpr (!Epi::AFTER_DRAIN) { E(acc, cur, wr, wc, fr, fq, est); S.done(cur); }
        if (!has_next) break;
#pragma unroll
        for (int a = 0; a < 2; ++a)
#pragma unroll
            for (int b = 0; b < 2; ++b)
#pragma unroll
                for (int m = 0; m < 4; ++m)
#pragma unroll
                    for (int n = 0; n < 2; ++n) acc[a][b][m][n] = (f32x4){0.f, 0.f, 0.f, 0.f};
        cur = nxt; cA = nA; cB = nB; ++ui;
        if constexpr (ALIGN_EPI) { if (wr == 1) PG8_BAR; }
    }
    PG8_WAIT_V(0);
    if constexpr (!ALIGN_EPI) { if (wr == 0) PG8_BAR; }
    PG8_BAR;
    if constexpr (Epi::AFTER_DRAIN) { E.fused(acc, cur, wr, wc, fr, fq, lds, wid, lane); S.done(cur); }
#undef PG8_SA
#undef PG8_SB
#undef PG8_STAGE
#undef PG8_LDA
#undef PG8_LDB
#undef PG8_MMA
#undef PG8_WAIT_V
#undef PG8_WAIT_L
#undef PG8_BAR
#undef PG8_SCHED
}
}

#define LAS __attribute__((address_space(3)))
typedef unsigned short bf16_t;
using pg8::bf16x8; using pg8::f32x4; using pg8::u32x4;
typedef unsigned u32x2 __attribute__((ext_vector_type(2)));
typedef short bf16x4 __attribute__((ext_vector_type(4)));

constexpr int NB = 4, T = 8192, D = 1024, M = NB * T, DEPTH = 4, NMEM = 256, MM = NB * NMEM;
constexpr int DIN = 2560, FF = 2816;
constexpr float EPS = 1e-6f, LOG2E = 1.4426950408889634f;
constexpr size_t MiB = 1u << 20;
constexpr size_t WS_CTL = 0, CTL_BYTES = 1 * MiB;
constexpr size_t WS_LB = 1 * MiB, WS_PART = 2 * MiB, WS_DBUF = 4 * MiB, WS_POOLT = 5 * MiB, WS_MEMN = 6 * MiB, WS_KB = 14 * MiB, WS_VTB = 22 * MiB, WS_WKV = 30 * MiB;
constexpr size_t WS_W13A = 46 * MiB, WS_W2A = 57 * MiB, WS_W13B = 63 * MiB, WS_W2B = 74 * MiB, WS_WIN = 80 * MiB, WS_WOUT = 85 * MiB, WS_WQ = 87 * MiB, WS_WO = 89 * MiB;
constexpr size_t WS_XB = 92 * MiB, WS_R1 = 156 * MiB, WS_SBUF = 332 * MiB, WS_OCAT = 396 * MiB, WS_XLO = 460 * MiB, WS_END = 492 * MiB;
constexpr int LDS_BYTES = 155648;
constexpr int NPHASE = 2 + 12 * DEPTH + (DEPTH - 1) + 1 - DEPTH;

struct Args { const float* in[23]; float* out; unsigned char* ws; int ph_lo, ph_hi; };

__device__ __forceinline__ float bf2f(unsigned b) { return __uint_as_float(b << 16); }
typedef float f32x2_t __attribute__((ext_vector_type(2))); typedef __bf16 bf16x2_t __attribute__((ext_vector_type(2)));
__device__ __forceinline__ unsigned pk2(float lo, float hi) { f32x2_t v = {lo, hi}; bf16x2_t b = __builtin_convertvector(v, bf16x2_t); return __builtin_bit_cast(unsigned, b); }
__device__ __forceinline__ float wave_sum(float v) {
#pragma unroll
    for (int o = 1; o < 64; o <<= 1) v += __shfl_xor(v, o);
    return v;
}
__device__ __forceinline__ float row_rstd(const float* part, int r) {
    const f32x4* p = (const f32x4*)(part + (size_t)r * 16);
    const f32x4 a = p[0], b = p[1], c = p[2], d = p[3];
    const float s = ((a.x + a.y) + (a.z + a.w)) + ((b.x + b.y) + (b.z + b.w)) + ((c.x + c.y) + (c.z + c.w)) + ((d.x + d.y) + (d.z + d.w));
    return rsqrtf(s * (1.f / 1024.f) + EPS);
}
#define LBAR() do { asm volatile("s_waitcnt lgkmcnt(0)" ::: "memory"); __builtin_amdgcn_s_barrier(); asm volatile("" ::: "memory"); } while (0)
__device__ __forceinline__ float silu_f(float x) { return x * __builtin_amdgcn_rcpf(1.f + __builtin_amdgcn_exp2f(-x * LOG2E)); }

__device__ __forceinline__ void rstd8(const float* part, int rowU0, int fr, int fq, float (&rs)[8]) {
    const unsigned vo = (unsigned)(fr * 16 + fq * 4);
#pragma unroll
    for (int i = 0; i < 8; ++i) { const float* pb = part + (size_t)(rowU0 + (i >> 2) * 128 + (i & 3) * 16) * 16; const f32x4 p = *(const f32x4*)(pb + vo); rs[i] = (p.x + p.y) + (p.z + p.w); }
#pragma unroll
    for (int i = 0; i < 8; ++i) { float s = rs[i]; s += __shfl_xor(s, 16); s += __shfl_xor(s, 32); rs[i] = rsqrtf(s * (1.f / 1024.f) + EPS); }
}
__device__ __forceinline__ void rs_cached(const float* part, LAS unsigned char* L, int rowU0, int wr, int wc, int fr, int fq, bool fresh, float (&rs)[8]) {
    LAS f32x4* slot = (LAS f32x4*)(L + 131072) + (((wr * 4 + wc) * 64 + fq * 16 + fr) * 2);
    if (fresh) { rstd8(part, rowU0, fr, fq, rs); slot[0] = (f32x4){rs[0], rs[1], rs[2], rs[3]}; slot[1] = (f32x4){rs[4], rs[5], rs[6], rs[7]}; }
    else { const f32x4 a = slot[0], b = slot[1]; rs[0] = a[0]; rs[1] = a[1]; rs[2] = a[2]; rs[3] = a[3]; rs[4] = b[0]; rs[5] = b[1]; rs[6] = b[2]; rs[7] = b[3]; }
}
template <bool SCALE> struct EpiScale {
    static constexpr bool PERM = true, AFTER_DRAIN = false;
    bf16_t* O; int ldc; const float* part; LAS unsigned char* L;
    struct State { int pm = -1; };
    __device__ __forceinline__ void operator()(const f32x4 (&acc)[2][2][4][2], const pg8::Unit& u, int wr, int wc, int fr, int fq, State& st) const {
        const int rowU0 = u.pm * 256 + wr * 64; const unsigned vo = (unsigned)(fr * ldc + wc * 32 + 8 * fq);
        float rs[8];
        if (SCALE) rs_cached(part, L, rowU0, wr, wc, fr, fq, st.pm != u.pm, rs);
        st.pm = u.pm;
#pragma unroll
        for (int ai = 0; ai < 2; ++ai)
#pragma unroll
            for (int m = 0; m < 4; ++m) { const float r_ = SCALE ? rs[ai * 4 + m] : 1.f;
                bf16_t* rowp = O + (size_t)(rowU0 + ai * 128 + m * 16) * ldc + u.pn * 256;
#pragma unroll
                for (int bj = 0; bj < 2; ++bj) { const f32x4 v0 = acc[ai][bj][m][0] * r_, v1 = acc[ai][bj][m][1] * r_;
                    u32x4 w; w.x = pk2(v0[0], v0[1]); w.y = pk2(v0[2], v0[3]); w.z = pk2(v1[0], v1[1]); w.w = pk2(v1[2], v1[3]);
                    *(u32x4*)(rowp + (vo + bj * 128)) = w; } }
    }
};
struct EpiSwiglu {
    static constexpr bool PERM = true, AFTER_DRAIN = false;
    bf16_t* G; const float* part; LAS unsigned char* L;
    struct State { int pm = -1; };
    __device__ __forceinline__ void operator()(const f32x4 (&acc)[2][2][4][2], const pg8::Unit& u, int wr, int wc, int fr, int fq, State& st) const {
        const int rowU0 = u.pm * 256 + wr * 64; const unsigned vo = (unsigned)(fr * FF + wc * 32 + 8 * fq);
        float rs[8];
        rs_cached(part, L, rowU0, wr, wc, fr, fq, st.pm != u.pm, rs);
        st.pm = u.pm;
#pragma unroll
        for (int ai = 0; ai < 2; ++ai)
#pragma unroll
            for (int m = 0; m < 4; ++m) { const float r_ = rs[ai * 4 + m], c_ = -r_ * LOG2E, r2_ = r_ * r_;
                f32x2_t g2[4];
#pragma unroll
                for (int n = 0; n < 2; ++n)
#pragma unroll
                    for (int jp = 0; jp < 2; ++jp) { const f32x2_t a1 = {acc[ai][0][m][n][2 * jp], acc[ai][0][m][n][2 * jp + 1]}, a3 = {acc[ai][1][m][n][2 * jp], acc[ai][1][m][n][2 * jp + 1]};
                        const f32x2_t t = a1 * c_; f32x2_t e; e.x = __builtin_amdgcn_exp2f(t.x); e.y = __builtin_amdgcn_exp2f(t.y);
                        const f32x2_t d = e + 1.f; f32x2_t q; q.x = __builtin_amdgcn_rcpf(d.x); q.y = __builtin_amdgcn_rcpf(d.y);
                        g2[n * 2 + jp] = ((a1 * a3) * r2_) * q; }
                u32x4 w; w.x = pk2(g2[0].x, g2[0].y); w.y = pk2(g2[1].x, g2[1].y); w.z = pk2(g2[2].x, g2[2].y); w.w = pk2(g2[3].x, g2[3].y);
                bf16_t* rowp = G + (size_t)(rowU0 + ai * 128 + m * 16) * FF + u.pn * 128;
                *(u32x4*)(rowp + vo) = w; }
    }
};
__device__ __forceinline__ float xs_join(unsigned hbits, unsigned nib_at_top) { return __uint_as_float(hbits + (unsigned)(((int)nib_at_top >> 28) << 12)); }
__device__ __forceinline__ unsigned xs_lo(float x, unsigned hbits) { int q = ((int)(__float_as_uint(x) - hbits) + 0x800) >> 12; q = q > 7 ? 7 : q; return (unsigned)q & 0xfu; }
struct EpiResid {
    static constexpr bool PERM = true, AFTER_DRAIN = false;
    bf16_t* XB; unsigned char* XL; float* part; float scale;
    struct State {};
    __device__ __forceinline__ void operator()(const f32x4 (&acc)[2][2][4][2], const pg8::Unit& u, int wr, int wc, int fr, int fq, State&) const {
        const int rowU0 = u.pm * 256 + wr * 64; const unsigned vo = (unsigned)(fr * D + wc * 32 + 8 * fq), vp = (unsigned)(fr * 16);
#pragma unroll
        for (int ai = 0; ai < 2; ++ai) {
            u32x4 xv[4][2]; unsigned lv[4][2];
#pragma unroll
            for (int m = 0; m < 4; ++m) { const size_t ro = (size_t)(rowU0 + ai * 128 + m * 16) * D + u.pn * 256; const bf16_t* brow = XB + ro; const unsigned char* lrow = XL + (ro >> 1);
#pragma unroll
                for (int bj = 0; bj < 2; ++bj) { xv[m][bj] = *(const u32x4*)(brow + (vo + bj * 128)); lv[m][bj] = *(const unsigned*)(lrow + ((vo + bj * 128) >> 1)); } }
#pragma unroll
            for (int m = 0; m < 4; ++m) { const size_t rU = (size_t)(rowU0 + ai * 128 + m * 16); float ss = 0.f;
                bf16_t* brow = XB + rU * D + u.pn * 256; unsigned char* lrow = XL + ((rU * D + u.pn * 256) >> 1);
#pragma unroll
                for (int bj = 0; bj < 2; ++bj) { const u32x4 xr = xv[m][bj]; const unsigned lr = lv[m][bj]; u32x4 w; unsigned lw = 0u;
#pragma unroll
                    for (int q = 0; q < 4; ++q) { const f32x4& av = acc[ai][bj][m][q >> 1];
                        const float lo = xs_join(xr[q] << 16, lr << (28 - 8 * q)) + av[(q & 1) * 2] * scale, hi = xs_join(xr[q] & 0xffff0000u, lr << (24 - 8 * q)) + av[(q & 1) * 2 + 1] * scale;
                        w[q] = pk2(lo, hi);
                        lw |= (xs_lo(lo, w[q] << 16) | (xs_lo(hi, w[q] & 0xffff0000u) << 4)) << (8 * q);
                        const float rl = bf2f(w[q] & 0xffffu), rh = __uint_as_float(w[q] & 0xffff0000u); ss += rl * rl + rh * rh; }
                    *(u32x4*)(brow + (vo + bj * 128)) = w; *(unsigned*)(lrow + ((vo + bj * 128) >> 1)) = lw; }
                ss += __shfl_xor(ss, 16); ss += __shfl_xor(ss, 32);
                float* pp = part + rU * 16 + u.pn * 4 + wc;
                if (fq == 0) pp[vp] = ss; }
            }
    }
};
struct SingleUnit { int pm, pn;
    __device__ __forceinline__ bool next(int i, pg8::Unit& u) const { if (i) return false; u.pm = pm; u.pn = pn; return true; }
    __device__ __forceinline__ void a_ready(const pg8::Unit&) const {}
    __device__ __forceinline__ void done(const pg8::Unit&) const {}
};

__device__ __forceinline__ void tr_item(const float* W, int ldw, int col0, int k0, const float* gain, float scale, bf16_t* dst, int ldd, int drow0, LAS float* scr, int lane) {
#pragma unroll 8
    for (int i = 0; i < 32; ++i) { const int kk = 2 * i + (lane >> 5); const float g = gain ? gain[k0 + kk] * scale : scale;
        scr[kk * 33 + (lane & 31)] = W[(size_t)(k0 + kk) * ldw + col0 + (lane & 31)] * g; }
    asm volatile("s_waitcnt lgkmcnt(0)" ::: "memory");
    const int c = lane & 7;
#pragma unroll
    for (int j = 0; j < 4; ++j) { const int n = (lane >> 3) + 8 * j; const LAS float* s = scr + (8 * c) * 33 + n;
        u32x4 o; o.x = pk2(s[0 * 33], s[1 * 33]); o.y = pk2(s[2 * 33], s[3 * 33]); o.z = pk2(s[4 * 33], s[5 * 33]); o.w = pk2(s[6 * 33], s[7 * 33]);
        *(u32x4*)(dst + (size_t)(drow0 + n) * ldd + k0 + 8 * c) = o; }
    asm volatile("s_waitcnt lgkmcnt(0)" ::: "memory");
}
__device__ __forceinline__ void conv_layer(const Args& a, int l, LAS float* scr, int gw, int NGW, int lane) {
    unsigned char* ws = a.ws;
    constexpr int I13 = 176 * 16, I2 = 32 * 44, IIN = 80 * 16, ISQ = 32 * 16, IPOOL = 32;
    constexpr int NIT = 2 * I13 + 2 * I2 + IIN + 3 * ISQ + IPOOL;
    for (int it = gw; it < NIT; it += NGW) {
        int r = it;
        if (r < 2 * I13) { const int second = r >= I13; if (second) r -= I13;
            const int rb = r >> 4, kb = r & 15, r0 = rb * 32, pn = r0 >> 8, within = r0 & 255;
            const float* src = (within < 128 ? a.in[second ? 19 : 3] : a.in[second ? 20 : 4]) + (size_t)l * D * FF;
            tr_item(src, FF, pn * 128 + (within & 127), kb * 64, a.in[second ? 18 : 2] + l * D, 1.f, (bf16_t*)(ws + (second ? WS_W13B : WS_W13A)), D, r0, scr, lane); continue; }
        r -= 2 * I13;
        if (r < 2 * I2) { const int second = r >= I2; if (second) r -= I2;
            const int rb = r / 44, kb = r % 44;
            tr_item(a.in[second ? 21 : 5] + (size_t)l * FF * D, D, rb * 32, kb * 64, nullptr, 1.f, (bf16_t*)(ws + (second ? WS_W2B : WS_W2A)), FF, rb * 32, scr, lane); continue; }
        r -= 2 * I2;
        if (r < IIN) { const int rb = r >> 4, kb = r & 15;
            tr_item(a.in[7] + (size_t)l * D * DIN, DIN, rb * 32, kb * 64, a.in[6] + l * D, 1.f, (bf16_t*)(ws + WS_WIN), D, rb * 32, scr, lane); continue; }
        r -= IIN;
        if (r < 3 * ISQ) { const int which = r / ISQ; r -= which * ISQ; const int rb = r >> 4, kb = r & 15;
            const float* src = a.in[which == 0 ? 12 : (which == 1 ? 15 : 17)] + (size_t)l * D * D;
            tr_item(src, D, rb * 32, kb * 64, which == 1 ? a.in[13] + l * D : nullptr, which == 1 ? 0.0625f : 1.f, (bf16_t*)(ws + (which == 0 ? WS_WOUT : (which == 1 ? WS_WQ : WS_WO))), D, rb * 32, scr, lane); continue; }
        r -= 3 * ISQ;
        { const int g = r >> 3, rr = r & 7, kb = rr & 1, rb = rr >> 1;
            tr_item(a.in[10] + (size_t)(l * 4 + g) * 128 * 128, 128, rb * 32, kb * 64, nullptr, 1.f, (bf16_t*)(ws + WS_POOLT) + g * 16384, 128, rb * 32, scr, lane); }
    }
}

__device__ __forceinline__ void p0_prologue(const Args& a, LAS unsigned char* L, int vcu, int G, int tid, int wave, int lane) {
    unsigned char* ws = a.ws;
    const int gw = vcu * 8 + wave, NGW = G * 8;
    LAS float* scr = (LAS float*)(L + wave * 16384);
    { const float* x = a.in[0]; bf16_t* XB = (bf16_t*)(ws + WS_XB); float* part = (float*)(ws + WS_PART);
      for (int m = gw; m < M; m += NGW) {
          const f32x4* xr = (const f32x4*)(x + (size_t)m * D) + lane;
          unsigned long long* o8 = (unsigned long long*)(XB + (size_t)m * D) + lane; unsigned short* l4 = (unsigned short*)(ws + WS_XLO + (size_t)m * (D / 2)) + lane;
          float s = 0.f;
#pragma unroll
          for (int j = 0; j < 4; ++j) { const f32x4 v = xr[64 * j]; const unsigned w0 = pk2(v.x, v.y), w1 = pk2(v.z, v.w);
              const float r0 = bf2f(w0 & 0xffffu), r1 = __uint_as_float(w0 & 0xffff0000u), r2 = bf2f(w1 & 0xffffu), r3 = __uint_as_float(w1 & 0xffff0000u); s += (r0 * r0 + r1 * r1) + (r2 * r2 + r3 * r3);
              o8[64 * j] = (unsigned long long)w0 | ((unsigned long long)w1 << 32);
              l4[64 * j] = (unsigned short)(xs_lo(v.x, w0 << 16) | (xs_lo(v.y, w0 & 0xffff0000u) << 4) | (xs_lo(v.z, w1 << 16) << 8) | (xs_lo(v.w, w1 & 0xffff0000u) << 12)); }
          s = wave_sum(s);
          if (lane < 16) part[(size_t)m * 16 + lane] = lane == 0 ? s : 0.f;
      } }
    { const float* mem = a.in[1]; bf16_t* MN = (bf16_t*)(ws + WS_MEMN);
      for (int m = gw; m < MM; m += NGW) {
          const f32x4* xr = (const f32x4*)(mem + (size_t)m * D) + lane; f32x4 v[4]; float s = 0.f;
#pragma unroll
          for (int j = 0; j < 4; ++j) { v[j] = xr[64 * j]; s += (v[j].x * v[j].x + v[j].y * v[j].y) + (v[j].z * v[j].z + v[j].w * v[j].w); }
          const float rs = rsqrtf(wave_sum(s) * (1.f / 1024.f) + EPS);
          for (int l = 0; l < DEPTH; ++l) { const f32x4* g = (const f32x4*)(a.in[14] + l * D) + lane;
              unsigned long long* o8 = (unsigned long long*)(MN + ((size_t)l * MM + m) * D) + lane;
#pragma unroll
              for (int j = 0; j < 4; ++j) { const f32x4 gg = g[64 * j]; const f32x4 y = v[j] * rs * gg;
                  o8[64 * j] = (unsigned long long)pk2(y.x, y.y) | ((unsigned long long)pk2(y.z, y.w) << 32); } }
      } }
    if (vcu == 0) { float* LB = (float*)(ws + WS_LB); const float* lg = a.in[8];
        const float e0 = lg[tid], e1 = lg[512 + tid], e2 = lg[1024 + tid], e3 = lg[1536 + tid];
        const float mx = fmaxf(fmaxf(e0, e1), fmaxf(e2, e3));
        const float p0 = __expf(e0 - mx), p1 = __expf(e1 - mx), p2 = __expf(e2 - mx), p3 = __expf(e3 - mx), inv = 1.f / (p0 + p1 + p2 + p3);
        LB[tid] = 0.f; LB[512 + tid] = p1 * inv; LB[1024 + tid] = (p1 + p2) * inv; LB[1536 + tid] = (p1 + p2 + p3) * inv; }
    for (int it = gw; it < 4096; it += NGW) { const int l = it >> 10, rr = it & 1023, rb = rr >> 4, kb = rr & 15;
        tr_item(a.in[16] + (size_t)l * D * 2048, 2048, rb * 32, kb * 64, nullptr, 1.f, (bf16_t*)(ws + WS_WKV) + (size_t)l * 2048 * D, D, rb * 32, scr, lane); }
    conv_layer(a, 0, scr, gw, NGW, lane);
}

__device__ __forceinline__ void e_pair_load(const bf16_t* P, int u, int pu, int tid, unsigned (&zr)[16], unsigned (&vr)[16], unsigned (&ur)[20]) {
    const int col = tid & 127, sg = tid >> 7;
    const int h = u & 3, c = (u >> 2) & 127, b = u >> 9, t0 = b * T + c * 64;
    const int g = pu & 3, tile = pu >> 2, pt0 = tile * 64, tpos0 = pt0 & (T - 1);
    const bf16_t* pz = P + (size_t)(t0 + 16 * sg) * DIN + 512 + h * 128 + col;
#pragma unroll
    for (int i = 0; i < 16; ++i) { zr[i] = pz[(size_t)i * DIN]; vr[i] = pz[(size_t)i * DIN + 512]; }
    const bf16_t* pu_ = P + 2048 + g * 128 + col;
#pragma unroll
    for (int j = 0; j < 20; ++j) { const int r = sg + 4 * j, tp = tpos0 - 15 + r; ur[j] = (r < 79 && tp >= 0) ? (unsigned)pu_[(size_t)(pt0 - 15 + r) * DIN] : 0u; }
}
__device__ __forceinline__ void e_unit_pair(LAS unsigned char* L, const float* LBl, bf16_t* SB, float* DB, const bf16_t* PT, const float* pscale, bf16_t* OC,
                                            int u, int pu, int tid, int wave, int lane, const unsigned (&zr)[16], const unsigned (&vr)[16], const unsigned (&ur)[20]) {
    int col = tid & 127, sg = tid >> 7, fr = lane & 15, fq = lane >> 4;
#define E_RELANE() do { int t_ = tid; asm volatile("" : "+v"(t_)); col = t_ & 127; sg = t_ >> 7; fr = t_ & 15; fq = (t_ >> 4) & 3; } while (0)
    const int h = u & 3, c = (u >> 2) & 127, b = u >> 9, t0 = b * T + c * 64, sidx = (b * 4 + h) * 128 + c;
    LAS float* tot = (LAS float*)L;
    LAS bf16_t* kT = (LAS bf16_t*)(L + 2048);
    LAS bf16_t* vT = (LAS bf16_t*)(L + 2048 + 128 * 144);
    const int g = pu & 3, tile = pu >> 2, pt0 = tile * 64, tpos0 = pt0 & (T - 1);
    LAS float* uL = (LAS float*)(L + 40960);
    LAS bf16_t* pL = (LAS bf16_t*)(L + 40960 + 79 * 128 * 4);
    const float lb = LBl[h * 128 + col], oml = 1.f - lb;
    float kk[16], cs[16]; float run = 0.f;
#pragma unroll
    for (int i = 0; i < 16; ++i) { float z = bf2f(zr[i]); z = fminf(fmaxf(z, -30.f), 30.f);
        const float sig = __builtin_amdgcn_rcpf(1.f + __builtin_amdgcn_exp2f(-z * LOG2E)), f = lb + oml * sig;
        run += __builtin_amdgcn_logf(f); cs[i] = run; kk[i] = 1.f - f; }
    tot[sg * 128 + col] = run;
#pragma unroll
    for (int j = 0; j < 20; ++j) { const int r = sg + 4 * j; if (r < 79) uL[r * 128 + col] = bf2f(ur[j]); }
    LBAR(); E_RELANE();
    { float pre = 0.f, btot = 0.f;
#pragma unroll
      for (int j = 0; j < 4; ++j) { const float tj = tot[j * 128 + col]; btot += tj; if (j < sg) pre += tj; }
      unsigned wk[8], wv[8];
#pragma unroll
      for (int i = 0; i < 8; ++i) { const float e0 = __builtin_amdgcn_exp2f(btot - (pre + cs[2 * i])), e1 = __builtin_amdgcn_exp2f(btot - (pre + cs[2 * i + 1]));
          wk[i] = pk2(kk[2 * i] * e0, kk[2 * i + 1] * e1); wv[i] = vr[2 * i] | (vr[2 * i + 1] << 16); }
      *(LAS u32x4*)(kT + col * 72 + 16 * sg) = (u32x4){wk[0], wk[1], wk[2], wk[3]}; *(LAS u32x4*)(kT + col * 72 + 16 * sg + 8) = (u32x4){wk[4], wk[5], wk[6], wk[7]};
      *(LAS u32x4*)(vT + col * 72 + 16 * sg) = (u32x4){wv[0], wv[1], wv[2], wv[3]}; *(LAS u32x4*)(vT + col * 72 + 16 * sg + 8) = (u32x4){wv[4], wv[5], wv[6], wv[7]};
      if (sg == 0) DB[(size_t)sidx * 128 + col] = __builtin_amdgcn_exp2f(btot); }
    { const int w = 2 << g, s0 = 16 * sg; float sum = 0.f;
      for (int j = 1; j < w; ++j) sum += uL[(15 + s0 - j) * 128 + col];
#pragma unroll
      for (int i = 0; i < 16; ++i) { const int s = s0 + i; const float cur = uL[(15 + s) * 128 + col]; sum += cur;
          const int cnt = min(tpos0 + s + 1, w);
          const float p = sum * __builtin_amdgcn_rcpf((float)cnt) - cur;
          pL[s * 136 + col] = (bf16_t)(pk2(p, 0.f) & 0xffffu);
          sum -= uL[(16 + s - w) * 128 + col]; } }
    LBAR(); E_RELANE();
    const int tb = wave >> 1, dh = wave & 1;
    const bf16_t* wt = PT + g * 16384;
    bf16x8 wfr[4][4]; f32x4 scv[4];
#pragma unroll
    for (int nt = 0; nt < 4; ++nt) { const int d0 = 64 * dh + 16 * nt;
#pragma unroll
        for (int k = 0; k < 4; ++k) wfr[nt][k] = *(const bf16x8*)(wt + (d0 + fr) * 128 + 32 * k + 8 * fq);
        scv[nt] = *(const f32x4*)(pscale + g * 128 + d0 + 4 * fq); }
    { const bf16x8 a0 = *(const LAS bf16x8*)(kT + (16 * wave + fr) * 72 + 8 * fq), a1 = *(const LAS bf16x8*)(kT + (16 * wave + fr) * 72 + 32 + 8 * fq);
      bf16_t* ut = SB + (size_t)sidx * 16384;
#pragma unroll
      for (int nt = 0; nt < 8; ++nt) {
          const bf16x8 b0 = *(const LAS bf16x8*)(vT + (16 * nt + fr) * 72 + 8 * fq), b1 = *(const LAS bf16x8*)(vT + (16 * nt + fr) * 72 + 32 + 8 * fq);
          f32x4 acc = {0.f, 0.f, 0.f, 0.f};
          acc = __builtin_amdgcn_mfma_f32_16x16x32_bf16(a0, b0, acc, 0, 0, 0);
          acc = __builtin_amdgcn_mfma_f32_16x16x32_bf16(a1, b1, acc, 0, 0, 0);
          *(u32x2*)(ut + (16 * nt + fr) * 128 + 16 * wave + 4 * fq) = (u32x2){pk2(acc[0], acc[1]), pk2(acc[2], acc[3])};
      } }
    { bf16x8 pf[4];
#pragma unroll
      for (int k = 0; k < 4; ++k) pf[k] = *(const LAS bf16x8*)(pL + (16 * tb + fr) * 136 + 32 * k + 8 * fq);
#pragma unroll
      for (int nt = 0; nt < 4; ++nt) { const int d0 = 64 * dh + 16 * nt; f32x4 acc = {0.f, 0.f, 0.f, 0.f};
#pragma unroll
          for (int k = 0; k < 4; ++k) acc = __builtin_amdgcn_mfma_f32_16x16x32_bf16(wfr[nt][k], pf[k], acc, 0, 0, 0);
          const f32x4 sc = scv[nt];
          *(u32x2*)(OC + (size_t)(pt0 + 16 * tb + fr) * D + 512 + g * 128 + d0 + 4 * fq) = (u32x2){pk2(acc[0] * sc[0], acc[1] * sc[1]), pk2(acc[2] * sc[2], acc[3] * sc[3])};
      } }
}
#undef E_RELANE

__device__ __forceinline__ void hgrn_scan(bf16_t* SB, const float* DB, int vcu, int G, int tid) {
    for (int e = vcu * 512 + tid; e < 16 * 8192; e += G * 512) {
        const int bh = e >> 13, pi = e & 8191;
        unsigned* sp = (unsigned*)(SB + (size_t)bh * 128 * 16384) + pi;
        const float* dp = DB + (size_t)bh * 128 * 128 + 2 * (pi & 63);
        float s0 = 0.f, s1 = 0.f;
        for (int c0 = 0; c0 < 128; c0 += 16) {
            unsigned uu[16]; float d0[16], d1[16];
#pragma unroll
            for (int i = 0; i < 16; ++i) { uu[i] = sp[(size_t)(c0 + i) * 8192]; const float2 dd = *(const float2*)(dp + (c0 + i) * 128); d0[i] = dd.x; d1[i] = dd.y; }
#pragma unroll
            for (int i = 0; i < 16; ++i) { sp[(size_t)(c0 + i) * 8192] = pk2(s0, s1);
                s0 = d0[i] * s0 + bf2f(uu[i] & 0xffffu); s1 = d1[i] * s1 + __uint_as_float(uu[i] & 0xffff0000u); }
        }
    }
}

constexpr int HOUT_LDS = 75776;
__device__ __forceinline__ void hgrn_out_pair(LAS unsigned char* L0, const bf16_t* P, const float* LBl, const bf16_t* SB, const float* hg, bf16_t* OC, int uA, int uB, int tid, int wave, int lane) {
    int col = tid & 127, sg = tid >> 7, fr = lane & 15, fq = lane >> 4; const int tb = wave >> 1, vh = wave & 1, sb = wave & 1;
#define HOUT_RELANE() do { int t_ = tid; asm volatile("" : "+v"(t_)); col = t_ & 127; sg = t_ >> 7; fr = t_ & 15; fq = (t_ >> 4) & 3; } while (0)
    int h[2], t0[2], sidx[2];
    float kk[2][16], cs[2][16], qv[2][16]; unsigned vr[2][16];
#pragma unroll
    for (int p = 0; p < 2; ++p) { const int u = p ? uB : uA; h[p] = u & 3; const int c = (u >> 2) & 127, b = u >> 9; t0[p] = b * T + c * 64; sidx[p] = (b * 4 + h[p]) * 128 + c; }
    unsigned qr[2][16], zr[2][16];
#pragma unroll
    for (int p = 0; p < 2; ++p) { const bf16_t* pq = P + (size_t)(t0[p] + 16 * sg) * DIN + h[p] * 128 + col;
#pragma unroll
        for (int i = 0; i < 16; ++i) { qr[p][i] = pq[(size_t)i * DIN]; zr[p][i] = pq[(size_t)i * DIN + 512]; vr[p][i] = pq[(size_t)i * DIN + 1024]; } }
#pragma unroll
    for (int p = 0; p < 2; ++p) { LAS float* tot = (LAS float*)(L0 + p * HOUT_LDS);
        const float lb = LBl[h[p] * 128 + col], oml = 1.f - lb; float run = 0.f;
#pragma unroll
        for (int i = 0; i < 16; ++i) { float z = bf2f(zr[p][i]); z = fminf(fmaxf(z, -30.f), 30.f);
            const float sig = __builtin_amdgcn_rcpf(1.f + __builtin_amdgcn_exp2f(-z * LOG2E)), f = lb + oml * sig;
            run += __builtin_amdgcn_logf(f); cs[p][i] = run; kk[p][i] = 1.f - f; qv[p][i] = bf2f(qr[p][i]); }
        tot[sg * 128 + col] = run; }
    LBAR(); HOUT_RELANE();
#pragma unroll
    for (int p = 0; p < 2; ++p) { LAS unsigned char* L = L0 + p * HOUT_LDS;
        LAS float* tot = (LAS float*)L; LAS bf16_t* qh = (LAS bf16_t*)(L + 4096); LAS bf16_t* k0L = (LAS bf16_t*)(L + 4096 + 17408); LAS bf16_t* q1L = (LAS bf16_t*)(L + 4096 + 26112);
        LAS bf16_t* k1L = (LAS bf16_t*)(L + 4096 + 34816); LAS bf16_t* vT = (LAS bf16_t*)(L + 4096 + 43520);
        float pre = 0.f;
#pragma unroll
        for (int j = 0; j < 4; ++j) { const float tj = tot[j * 128 + col]; if (j < sg) pre += tj; }
        const float b31 = tot[col] + tot[128 + col];
#pragma unroll
        for (int i = 0; i < 16; ++i) { const int s = 16 * sg + i; const float bb = pre + cs[p][i];
            qh[s * 136 + col] = (bf16_t)(pk2(qv[p][i] * __builtin_amdgcn_exp2f(bb), 0.f) & 0xffffu);
            if (sg < 2) { k0L[s * 136 + col] = (bf16_t)(pk2(kk[p][i] * __builtin_amdgcn_exp2f(fminf(-bb, 115.f)), 0.f) & 0xffffu); }
            else { q1L[(s - 32) * 136 + col] = (bf16_t)(pk2(qv[p][i] * __builtin_amdgcn_exp2f(bb - b31), 0.f) & 0xffffu);
                   k1L[(s - 32) * 136 + col] = (bf16_t)(pk2(kk[p][i] * __builtin_amdgcn_exp2f(fminf(b31 - bb, 115.f)), 0.f) & 0xffffu); } }
        unsigned wv[8];
#pragma unroll
        for (int i = 0; i < 8; ++i) wv[i] = vr[p][2 * i] | (vr[p][2 * i + 1] << 16);
        *(LAS u32x4*)(vT + col * 72 + 16 * sg) = (u32x4){wv[0], wv[1], wv[2], wv[3]}; *(LAS u32x4*)(vT + col * 72 + 16 * sg + 8) = (u32x4){wv[4], wv[5], wv[6], wv[7]}; }
    HOUT_RELANE();
    bf16x8 sfr[2][4][4];
#pragma unroll
    for (int p = 0; p < 2; ++p) { const bf16_t* st = SB + (size_t)sidx[p] * 16384;
#pragma unroll
        for (int nt = 0; nt < 4; ++nt)
#pragma unroll
            for (int k = 0; k < 4; ++k) sfr[p][nt][k] = *(const bf16x8*)(st + (64 * vh + 16 * nt + fr) * 128 + 32 * k + 8 * fq); }
    LBAR(); HOUT_RELANE();
#pragma unroll
    for (int p = 0; p < 2; ++p) { LAS unsigned char* L = L0 + p * HOUT_LDS;
        LAS bf16_t* qh = (LAS bf16_t*)(L + 4096); LAS bf16_t* k0L = (LAS bf16_t*)(L + 4096 + 17408); LAS bf16_t* q1L = (LAS bf16_t*)(L + 4096 + 26112);
        LAS bf16_t* k1L = (LAS bf16_t*)(L + 4096 + 34816); LAS bf16_t* aL = (LAS bf16_t*)(L + 4096 + 61952);
        f32x4 acc = {0.f, 0.f, 0.f, 0.f};
#pragma unroll
        for (int k = 0; k < 4; ++k) { const bf16x8 kf = *(const LAS bf16x8*)(k0L + (16 * sb + fr) * 136 + 32 * k + 8 * fq), qf = *(const LAS bf16x8*)(qh + (16 * tb + fr) * 136 + 32 * k + 8 * fq);
            acc = __builtin_amdgcn_mfma_f32_16x16x32_bf16(kf, qf, acc, 0, 0, 0); }
        const int t = 16 * tb + fr, s0 = 16 * sb + 4 * fq;
#pragma unroll
        for (int j = 0; j < 4; ++j) if (s0 + j > t) acc[j] = 0.f;
        *(LAS u32x2*)(aL + t * 72 + s0) = (u32x2){pk2(acc[0], acc[1]), pk2(acc[2], acc[3])};
        if (wave < 4) { f32x4 ac2 = {0.f, 0.f, 0.f, 0.f};
#pragma unroll
            for (int k = 0; k < 4; ++k) { const bf16x8 kf = *(const LAS bf16x8*)(k1L + (16 * sb + fr) * 136 + 32 * k + 8 * fq), qf = *(const LAS bf16x8*)(q1L + (16 * tb + fr) * 136 + 32 * k + 8 * fq);
                ac2 = __builtin_amdgcn_mfma_f32_16x16x32_bf16(kf, qf, ac2, 0, 0, 0); }
            const int t2 = 32 + 16 * tb + fr, s2 = 32 + 16 * sb + 4 * fq;
#pragma unroll
            for (int j = 0; j < 4; ++j) if (s2 + j > t2) ac2[j] = 0.f;
            *(LAS u32x2*)(aL + t2 * 72 + s2) = (u32x2){pk2(ac2[0], ac2[1]), pk2(ac2[2], ac2[3])};
        } else { const int Lx = (wave - 4) * 64 + lane; unsigned z_; asm volatile("v_mov_b32 %0, 0" : "=v"(z_));
            *(LAS u32x2*)(aL + (Lx >> 3) * 72 + 32 + 4 * (Lx & 7)) = (u32x2){z_, z_}; } }
    LBAR(); HOUT_RELANE();
    f32x4 o[2][4]; u32x2 gbr[2][4];
#pragma unroll
    for (int p = 0; p < 2; ++p) { LAS unsigned char* L = L0 + p * HOUT_LDS;
        LAS float* ssL = (LAS float*)(L + 2048); LAS bf16_t* qh = (LAS bf16_t*)(L + 4096); LAS bf16_t* vT = (LAS bf16_t*)(L + 4096 + 43520); LAS bf16_t* aL = (LAS bf16_t*)(L + 4096 + 61952);
        bf16x8 af[2], qf[4];
#pragma unroll
        for (int k = 0; k < 2; ++k) af[k] = *(const LAS bf16x8*)(aL + (16 * tb + fr) * 72 + 32 * k + 8 * fq);
#pragma unroll
        for (int k = 0; k < 4; ++k) qf[k] = *(const LAS bf16x8*)(qh + (16 * tb + fr) * 136 + 32 * k + 8 * fq);
        float ss = 0.f;
#pragma unroll
        for (int nt = 0; nt < 4; ++nt) { const int v0 = 64 * vh + 16 * nt; f32x4 acc = {0.f, 0.f, 0.f, 0.f};
#pragma unroll
            for (int k = 0; k < 2; ++k) { const bf16x8 vf = *(const LAS bf16x8*)(vT + (v0 + fr) * 72 + 32 * k + 8 * fq); acc = __builtin_amdgcn_mfma_f32_16x16x32_bf16(vf, af[k], acc, 0, 0, 0); }
#pragma unroll
            for (int k = 0; k < 4; ++k) acc = __builtin_amdgcn_mfma_f32_16x16x32_bf16(sfr[p][nt][k], qf[k], acc, 0, 0, 0);
            o[p][nt] = acc; ss += (acc[0] * acc[0] + acc[1] * acc[1]) + (acc[2] * acc[2] + acc[3] * acc[3]); }
        ss += __shfl_xor(ss, 16); ss += __shfl_xor(ss, 32);
        if (fq == 0) ssL[(16 * tb + fr) * 2 + vh] = ss; }
#pragma unroll
    for (int p = 0; p < 2; ++p) { const size_t tok = (size_t)(t0[p] + 16 * tb + fr);
#pragma unroll
        for (int nt = 0; nt < 4; ++nt) gbr[p][nt] = *(const u32x2*)(P + tok * DIN + 1536 + h[p] * 128 + 64 * vh + 16 * nt + 4 * fq); }
    LBAR(); HOUT_RELANE();
#pragma unroll
    for (int p = 0; p < 2; ++p) { LAS float* ssL = (LAS float*)(L0 + p * HOUT_LDS + 2048);
        const float rinv = rsqrtf((ssL[(16 * tb + fr) * 2] + ssL[(16 * tb + fr) * 2 + 1]) * (1.f / 128.f) + EPS);
        const size_t tok = (size_t)(t0[p] + 16 * tb + fr);
#pragma unroll
        for (int nt = 0; nt < 4; ++nt) { const int v0 = 64 * vh + 16 * nt + 4 * fq;
            const u32x2 gb = gbr[p][nt]; const f32x4 hgv = *(const f32x4*)(hg + h[p] * 128 + v0);
            const float g0 = silu_f(bf2f(gb.x & 0xffffu)), g1 = silu_f(__uint_as_float(gb.x & 0xffff0000u)), g2 = silu_f(bf2f(gb.y & 0xffffu)), g3 = silu_f(__uint_as_float(gb.y & 0xffff0000u));
            *(u32x2*)(OC + tok * D + h[p] * 128 + v0) = (u32x2){pk2(o[p][nt][0] * rinv * hgv[0] * g0, o[p][nt][1] * rinv * hgv[1] * g1), pk2(o[p][nt][2] * rinv * hgv[2] * g2, o[p][nt][3] * rinv * hgv[3] * g3)}; } }
}
#undef HOUT_RELANE

typedef float f32x16 __attribute__((ext_vector_type(16)));
#define MFMA32(a, b, c) __builtin_amdgcn_mfma_f32_32x32x16_bf16((a), (b), (c), 0, 0, 0)
__device__ __forceinline__ void attn_unit(LAS unsigned char* L, const bf16_t* Q, const bf16_t* Kl, const bf16_t* VTl, bf16_t* AO, int unit, int tid, int wave, int lane) {
    const int bh = unit >> 5, qb = unit & 31, b = bh >> 2, h = bh & 3, r = lane & 31, hh = lane >> 5;
    LAS bf16_t* kL = (LAS bf16_t*)L;
    const int frow = tid >> 5, fc16 = tid & 31;
    { const u32x4* src = (const u32x4*)(Kl + (size_t)(b * 256 + 16 * frow) * D + h * 256) + fc16; u32x4 t[16];
#pragma unroll
      for (int i = 0; i < 16; ++i) t[i] = src[(size_t)i * (D / 8)];
#pragma unroll
      for (int i = 0; i < 16; ++i) *(LAS u32x4*)(kL + (16 * frow + i) * 264 + 8 * fc16) = t[i]; }
    const size_t q0 = (size_t)b * T + (size_t)qb * 256 + 32 * wave;
    bf16x8 qf[16];
#pragma unroll
    for (int ks = 0; ks < 16; ++ks) qf[ks] = *(const bf16x8*)(Q + (q0 + r) * D + h * 256 + 16 * ks + 8 * hh);
    LBAR();
    bf16x8 pA[8], pB[8]; float mA, lA, mB, lB;
#define ATTN_S_HALF(KT0, PF, MX, LS) { f32x16 sacc[4]; \
        _Pragma("unroll") for (int t = 0; t < 4; ++t) _Pragma("unroll") for (int i = 0; i < 16; ++i) sacc[t][i] = 0.f; \
        _Pragma("unroll") for (int ks = 0; ks < 16; ++ks) _Pragma("unroll") for (int t = 0; t < 4; ++t) { \
            const bf16x8 kf = *(const LAS bf16x8*)(kL + (32 * ((KT0) + t) + r) * 264 + 16 * ks + 8 * hh); sacc[t] = MFMA32(kf, qf[ks], sacc[t]); if (t == 3) __builtin_amdgcn_sched_barrier(0); } \
        float mx_ = -3.0e38f; \
        _Pragma("unroll") for (int t = 0; t < 4; ++t) _Pragma("unroll") for (int i = 0; i < 16; ++i) mx_ = fmaxf(mx_, sacc[t][i]); \
        mx_ = fmaxf(mx_, __shfl_xor(mx_, 32)); const float mb_ = mx_ * LOG2E; float ls_ = 0.f; \
        _Pragma("unroll") for (int t = 0; t < 4; ++t) _Pragma("unroll") for (int i = 0; i < 16; ++i) { const float p_ = __builtin_amdgcn_exp2f(sacc[t][i] * LOG2E - mb_); sacc[t][i] = p_; ls_ += p_; } \
        ls_ += __shfl_xor(ls_, 32); MX = mx_; LS = ls_; \
        _Pragma("unroll") for (int t = 0; t < 4; ++t) _Pragma("unroll") for (int s = 0; s < 2; ++s) { \
            const u32x4 w_ = {pk2(sacc[t][8 * s], sacc[t][8 * s + 1]), pk2(sacc[t][8 * s + 2], sacc[t][8 * s + 3]), pk2(sacc[t][8 * s + 4], sacc[t][8 * s + 5]), pk2(sacc[t][8 * s + 6], sacc[t][8 * s + 7])}; \
            PF[t * 2 + s] = __builtin_bit_cast(bf16x8, w_); } }
    ATTN_S_HALF(0, pA, mA, lA)
    ATTN_S_HALF(4, pB, mB, lB)
#undef ATTN_S_HALF
    const float mm = fmaxf(mA, mB), eA = __builtin_amdgcn_exp2f((mA - mm) * LOG2E), eB = __builtin_amdgcn_exp2f((mB - mm) * LOG2E);
    const float linv = 1.f / (lA * eA + lB * eB), cA = eA * linv, cB = eB * linv;
    LBAR();
    { const u32x4* src = (const u32x4*)(VTl + (size_t)(h * 256 + 16 * frow) * MM + b * 256) + fc16; u32x4 t[16];
#pragma unroll
      for (int i = 0; i < 16; ++i) t[i] = src[(size_t)i * (MM / 8)];
#pragma unroll
      for (int i = 0; i < 16; ++i) { LAS bf16_t* d = kL + (16 * frow + i) * 264 + 16 * (fc16 >> 1) + ((fc16 & 1) ? 4 : 0);
          *(LAS u32x2*)d = (u32x2){t[i].x, t[i].y}; *(LAS u32x2*)(d + 8) = (u32x2){t[i].z, t[i].w}; } }
    LBAR();
    bf16_t* orow = AO + (q0 + r) * D + h * 256 + 4 * hh;
#pragma unroll 2
    for (int dt = 0; dt < 8; ++dt) { f32x16 oa, ob;
#pragma unroll
        for (int i = 0; i < 16; ++i) { oa[i] = 0.f; ob[i] = 0.f; }
        const LAS bf16_t* vrow = kL + (32 * dt + r) * 264 + 8 * hh;
#pragma unroll
        for (int k = 0; k < 8; ++k) { const bf16x8 va = *(const LAS bf16x8*)(vrow + 16 * k), vb = *(const LAS bf16x8*)(vrow + 128 + 16 * k);
            oa = MFMA32(va, pA[k], oa); ob = MFMA32(vb, pB[k], ob); if (k & 1) __builtin_amdgcn_sched_barrier(0); }
#pragma unroll
        for (int g = 0; g < 4; ++g) { const float o0 = oa[4 * g] * cA + ob[4 * g] * cB, o1 = oa[4 * g + 1] * cA + ob[4 * g + 1] * cB, o2 = oa[4 * g + 2] * cA + ob[4 * g + 2] * cB, o3 = oa[4 * g + 3] * cA + ob[4 * g + 3] * cB;
            *(u32x2*)(orow + 32 * dt + 8 * g) = (u32x2){pk2(o0, o1), pk2(o2, o3)}; }
    }
    LBAR();
}

#define RLX_AGENT __ATOMIC_RELAXED, __HIP_MEMORY_SCOPE_AGENT
#define XB_TMO      128
#define XB_XCNT(j)  (256  + 64 * (j))
#define XB_XSUB(j)  (1280 + 64 * (j))
#define XB_XGEN(j)  (2304 + 64 * (j))
#define XB_TOP      3328
#define XB_TOPGEN   3392
#define XCD_BAR_WORDS 3456
#define XB_SPIN_CAP (1u << 18)

__device__ __forceinline__ unsigned xb_ld(unsigned* p)              { return __hip_atomic_load(p, __ATOMIC_RELAXED, __HIP_MEMORY_SCOPE_AGENT); }
__device__ __forceinline__ unsigned xb_add(unsigned* p, unsigned v) { return __hip_atomic_fetch_add(p, v, __ATOMIC_RELAXED, __HIP_MEMORY_SCOPE_AGENT); }
__device__ __forceinline__ unsigned xb_xcc_id() { return (unsigned)__builtin_amdgcn_s_getreg((3 << 11) | 20) & 0xFu; }
#define XB_SPIN(cond, bar) do { unsigned _sp = 0; while (cond) { __builtin_amdgcn_s_sleep(1); \
    if ((++_sp & 255u) == 0u) { if (xb_ld(&(bar)[XB_TMO])) break; if (_sp > XB_SPIN_CAP) { atomicAdd(&(bar)[XB_TMO], 1u); break; } } } } while (0)

struct XcdBarrier {
    unsigned* bar; unsigned x;
    volatile LAS unsigned* st;
};

__device__ __forceinline__ XcdBarrier xcd_barrier_post(unsigned* bar, volatile LAS unsigned* st) {
    XcdBarrier b; b.bar = bar; b.x = xb_xcc_id(); b.st = st;
    if (threadIdx.x == 0) (void)xb_add(&bar[XB_XCNT(b.x)], 1u);
    return b;
}
__device__ __forceinline__ void xcd_barrier_complete(unsigned* bar, unsigned x, unsigned& nloc, unsigned& nx) {
    const unsigned G = gridDim.x * gridDim.y * gridDim.z;
    unsigned sum, cnt, mine, sp = 0u;
    for (;;) {
        sum = 0u; cnt = 0u; mine = 0u;
#pragma unroll
        for (unsigned j = 0; j < 16; ++j) { const unsigned c = xb_ld(&bar[XB_XCNT(j)]); sum += c; cnt += (c > 0u) ? 1u : 0u; mine = (j == x) ? c : mine; }
        if (sum == G) break;
        __builtin_amdgcn_s_sleep(1);
        if ((++sp & 255u) == 0u) { if (xb_ld(&bar[XB_TMO])) break; if (sp > XB_SPIN_CAP) { atomicAdd(&bar[XB_TMO], 1u); break; } }
    }
    nloc = mine > 0u ? mine : 1u; nx = cnt > 0u ? cnt : 1u;
}

__device__ __forceinline__ void xcd_barrier(const XcdBarrier& b) {
    asm volatile("s_waitcnt vmcnt(0)" ::: "memory");
    __syncthreads();
    if (threadIdx.x == 0) {
        unsigned* bar = b.bar;
        __builtin_amdgcn_s_waitcnt(0);
        unsigned nloc = b.st[0], nx = b.st[1];
        if (nloc == 0u) { xcd_barrier_complete(bar, b.x, nloc, nx); b.st[0] = nloc; b.st[1] = nx; }
        const unsigned old = xb_add(&bar[XB_XSUB(b.x)], 1u);
        const unsigned gen = old / nloc;
        if (old + 1u == (gen + 1u) * nloc) {
            __builtin_amdgcn_fence(__ATOMIC_RELEASE, "agent");
            asm volatile("s_waitcnt vmcnt(0)" ::: "memory");
            const unsigned og = xb_add(&bar[XB_TOP], 1u);
            const unsigned tg = og / nx;
            if (og + 1u == (tg + 1u) * nx) xb_add(&bar[XB_TOPGEN], 1u);
            else XB_SPIN(xb_ld(&bar[XB_TOPGEN]) == tg, bar);
            __builtin_amdgcn_fence(__ATOMIC_ACQUIRE, "agent");
            xb_add(&bar[XB_XGEN(b.x)], 1u);
            asm volatile("s_waitcnt vmcnt(0)" ::: "memory");
        } else {
            XB_SPIN(xb_ld(&bar[XB_XGEN(b.x)]) == gen, bar);
            __builtin_amdgcn_fence(__ATOMIC_ACQUIRE, "agent");
            asm volatile("s_waitcnt vmcnt(0)" ::: "memory");
        }
    }
    __syncthreads();
}

__global__ void __launch_bounds__(512, 2) hymba_fwd(Args a) {
    extern __shared__ __attribute__((aligned(16))) unsigned char lds_raw[];
    LAS unsigned char* L = (LAS unsigned char*)lds_raw;
    const int G = gridDim.x, bx = blockIdx.x, vcu = (G % 8 == 0) ? (bx % 8) * (G / 8) + bx / 8 : bx;
    const int NGW = G * 8;
    unsigned char* ws = a.ws;
    const int lo = a.ph_lo, hi = a.ph_hi;
    int pc = 0;
    volatile LAS unsigned* MISC = (volatile LAS unsigned*)(L + LDS_BYTES - 64);
    if (threadIdx.x < 16) MISC[threadIdx.x] = 0u;
    __syncthreads();
    const XcdBarrier bar = xcd_barrier_post((unsigned*)(a.ws + WS_CTL), MISC);
#define GRID_BAR() do { if (pc == 1) cg::this_grid().sync(); else xcd_barrier(bar); } while (0)
#define PH_BEGIN if (pc >= lo && pc < hi) { int tid = threadIdx.x; asm volatile("" : "+v"(tid)); const int lane = tid & 63, wave = __builtin_amdgcn_readfirstlane(tid >> 6), gw = vcu * 8 + wave; (void)lane; (void)gw;
#define PH_END } { ++pc; if (pc > lo && pc < hi) GRID_BAR(); }
#define GEMM_STATIC(EPI, Aptr, Btptr, Mv, Nv, Kv, Eobj) do { pg8::Gemm g_{(const bf16_t*)(Aptr), (const bf16_t*)(Btptr), Mv, Nv, Kv}; pg8::StaticOrder S_; S_.init(Mv, Nv, G, bx); \
        pg8::gemm_phase<EPI, pg8::StaticOrder, true, true>(L, g_, S_, Eobj); } while (0)

    PH_BEGIN p0_prologue(a, L, vcu, G, tid, wave, lane); PH_END
    PH_BEGIN
        for (int it = bx; it < 128; it += G) { const int gi = it >> 4, tile = it & 15, l = gi >> 1, isv = gi & 1;
            const bf16_t* mn = (const bf16_t*)(ws + WS_MEMN) + (size_t)l * MM * D; const bf16_t* wkv = (const bf16_t*)(ws + WS_WKV) + (size_t)l * 2048 * D;
            pg8::Gemm g_{isv ? wkv + (size_t)1024 * D : mn, isv ? mn : wkv, 1024, 1024, 1024};
            SingleUnit S_{tile >> 2, tile & 3};
            EpiScale<false> E_{(bf16_t*)(ws + (isv ? WS_VTB : WS_KB)) + (size_t)l * MM * D, 1024, nullptr, L};
            pg8::gemm_phase<EpiScale<false>, SingleUnit, false, true>(L, g_, S_, E_); }
    PH_END
    for (int l = 0; l < DEPTH; ++l) {
        size_t zoff = 0; int bx = blockIdx.x;
        asm volatile("" : "+s"(zoff), "+s"(bx));
        unsigned char* ws = a.ws + zoff;
        bf16_t* XB = (bf16_t*)(ws + WS_XB); float* PART = (float*)(ws + WS_PART);
        bf16_t* R1 = (bf16_t*)(ws + WS_R1); bf16_t* SB = (bf16_t*)(ws + WS_SBUF); bf16_t* OC = (bf16_t*)(ws + WS_OCAT); float* DB = (float*)(ws + WS_DBUF);
        if (l > 0) { PH_BEGIN conv_layer(a, l, (LAS float*)(L + wave * 16384), gw, NGW, lane); PH_END }
        PH_BEGIN { EpiSwiglu E_{R1, PART, L}; GEMM_STATIC(EpiSwiglu, XB, ws + WS_W13A, M, 2 * FF, D, E_); } PH_END
        PH_BEGIN { EpiResid E_{XB, ws + WS_XLO, PART, 0.5f}; GEMM_STATIC(EpiResid, R1, ws + WS_W2A, M, D, FF, E_); } PH_END
        PH_BEGIN { EpiScale<true> E_{R1, DIN, PART, L}; GEMM_STATIC(EpiScale<true>, XB, ws + WS_WIN, M, DIN, D, E_); } PH_END
        PH_BEGIN
            if (G == 256) {
                unsigned za[16], va[16], ua[20], zb[16], vb[16], ub[20];
                e_pair_load(R1, vcu, vcu, tid, za, va, ua);
                for (int i = 0; i < 8; i += 2) {
                    { const int un = vcu + (i + 1) * 256; e_pair_load(R1, un, un, tid, zb, vb, ub); }
                    { const int u = vcu + i * 256; e_unit_pair(L, (const float*)(ws + WS_LB) + l * 512, SB, DB, (const bf16_t*)(ws + WS_POOLT), a.in[11] + l * 512, OC, u, u, tid, wave, lane, za, va, ua); LBAR(); }
                    { const int un = vcu + (i + 2 < 8 ? i + 2 : 7) * 256; e_pair_load(R1, un, un, tid, za, va, ua); }
                    { const int u = vcu + (i + 1) * 256; e_unit_pair(L, (const float*)(ws + WS_LB) + l * 512, SB, DB, (const bf16_t*)(ws + WS_POOLT), a.in[11] + l * 512, OC, u, u, tid, wave, lane, zb, vb, ub); LBAR(); }
                }
            } else for (int u = vcu; u < 2048; u += G) { unsigned za[16], va[16], ua[20];
                e_pair_load(R1, u, u, tid, za, va, ua);
                e_unit_pair(L, (const float*)(ws + WS_LB) + l * 512, SB, DB, (const bf16_t*)(ws + WS_POOLT), a.in[11] + l * 512, OC, u, u, tid, wave, lane, za, va, ua);
                LBAR(); }
        PH_END
        PH_BEGIN hgrn_scan(SB, DB, vcu, G, tid); PH_END
        PH_BEGIN
            for (int u = vcu; u < 2048; u += 2 * G) { hgrn_out_pair(L, R1, (const float*)(ws + WS_LB) + l * 512, SB, a.in[9] + l * 512, OC, u, u + G, tid, wave, lane); LBAR(); }
        PH_END
        PH_BEGIN { EpiResid E_{XB, ws + WS_XLO, PART, 1.f}; GEMM_STATIC(EpiResid, OC, ws + WS_WOUT, M, D, D, E_); } PH_END
        PH_BEGIN
            { EpiScale<true> E_{R1, D, PART, L}; GEMM_STATIC(EpiScale<true>, XB, ws + WS_WQ, M, D, D, E_); }
            asm volatile("s_waitcnt vmcnt(0)" ::: "memory"); __syncthreads(); __builtin_amdgcn_fence(__ATOMIC_ACQUIRE, "agent");
            { pg8::StaticOrder S_; S_.init(M, D, G, bx); pg8::Unit u_; int tid = threadIdx.x; asm volatile("" : "+v"(tid)); const int lane = tid & 63, wave = __builtin_amdgcn_readfirstlane(tid >> 6);
              for (int i = 0; S_.next(i, u_); ++i)
                  attn_unit(L, R1, (const bf16_t*)(ws + WS_KB) + (size_t)l * MM * D, (const bf16_t*)(ws + WS_VTB) + (size_t)l * MM * D, R1 + (size_t)M * D, (((u_.pm >> 5) * 4 + u_.pn) << 5) + (u_.pm & 31), tid, wave, lane); }
        PH_END
        PH_BEGIN { EpiResid E_{XB, ws + WS_XLO, PART, 1.f}; GEMM_STATIC(EpiResid, R1 + (size_t)M * D, ws + WS_WO, M, D, D, E_); } PH_END
        PH_BEGIN { EpiSwiglu E_{R1, PART, L}; GEMM_STATIC(EpiSwiglu, XB, ws + WS_W13B, M, 2 * FF, D, E_); } PH_END
        PH_BEGIN { EpiResid E_{XB, ws + WS_XLO, PART, 0.5f}; GEMM_STATIC(EpiResid, R1, ws + WS_W2B, M, D, FF, E_); } PH_END
    }
    PH_BEGIN
        const bf16_t* XBf = (const bf16_t*)(ws + WS_XB); const float* PART = (const float*)(ws + WS_PART);
        for (int m = gw; m < M; m += NGW) { const float rs = row_rstd(PART, m); f32x4* orow = (f32x4*)(a.out + (size_t)m * D) + lane; const f32x4* g = (const f32x4*)a.in[22] + lane;
            const u32x2* xr = (const u32x2*)(XBf + (size_t)m * D) + lane; const unsigned short* lr = (const unsigned short*)(ws + WS_XLO + (size_t)m * (D / 2)) + lane;
#pragma unroll
            for (int j = 0; j < 4; ++j) { const u32x2 w = xr[64 * j]; const unsigned q = lr[64 * j];
                const f32x4 v = {xs_join(w.x << 16, q << 28), xs_join(w.x & 0xffff0000u, q << 24), xs_join(w.y << 16, q << 20), xs_join(w.y & 0xffff0000u, q << 16)};
                orow[64 * j] = v * rs * g[64 * j]; } }
    PH_END
}

extern "C" void kernel_launch(void* const* d_in, const int* in_sizes, int n_in, void* d_out, int out_size, void* d_ws, size_t ws_size, hipStream_t stream) {
    static int grid = 0;
    if (grid == 0) {
        int dev = 0, cus = 0, per_cu = 0;
        if (n_in != 23 || ws_size < WS_END) { fprintf(stderr, "kernel_launch: unexpected n_in %d / ws %zu\n", n_in, ws_size); grid = -1; return; }
        hipGetDevice(&dev); hipDeviceGetAttribute(&cus, hipDeviceAttributeMultiprocessorCount, dev);
        if (hipFuncSetAttribute((const void*)hymba_fwd, hipFuncAttributeMaxDynamicSharedMemorySize, LDS_BYTES) != hipSuccess) { fprintf(stderr, "kernel_launch: hipFuncSetAttribute failed\n"); grid = -1; return; }
        hipOccupancyMaxActiveBlocksPerMultiprocessor(&per_cu, (const void*)hymba_fwd, 512, LDS_BYTES);
        (void)hipGetLastError();
        if (per_cu < 1) fprintf(stderr, "kernel_launch: occupancy query says %d\n", per_cu);
        grid = cus > 0 ? cus : 256;
    }
    if (grid < 0) return;
    if (hipMemsetAsync((char*)d_ws + WS_CTL, 0, 16384, stream) != hipSuccess) { fprintf(stderr, "kernel_launch: memset failed\n"); return; }
    Args a{};
    for (int i = 0; i < 23; ++i) a.in[i] = (const float*)d_in[i];
    a.out = (float*)d_out; a.ws = (unsigned char*)d_ws;
    a.ph_lo = 0; a.ph_hi = NPHASE;
    void* args[] = {&a};
    hipError_t e = hipLaunchCooperativeKernel((const void*)hymba_fwd, dim3(grid), dim3(512), args, LDS_BYTES, stream);
    if (e != hipSuccess) fprintf(stderr, "cooperative launch failed: %s (grid %d)\n", hipGetErrorString(e), grid);
}
```

```cpp
#include <hip/hip_runtime.h>
#include <hip/hip_cooperative_groups.h>
#include <cstdio>
namespace cg = cooperative_groups;
namespace pg8 {
#define PG8_LAS __attribute__((address_space(3)))
typedef unsigned short bf16_t;
typedef short bf16x8 __attribute__((ext_vector_type(8)));
typedef float f32x4 __attribute__((ext_vector_type(4)));
typedef unsigned u32x4 __attribute__((ext_vector_type(4)));
constexpr int BM = 256, BK = 64, HALF = 128, HTB = HALF * BK * 2  , STAGE_BYTES = 8 * HTB, NXCD = 8, WGM = 8;

__host__ __device__ __forceinline__ int lds_byte(int r, int c) { const int st = (r >> 4) * 2 + (c >> 5), rr = r & 15, cc = c & 31, ob = rr * 64 + cc * 2; return st * 1024 + (ob ^ (((ob >> 9) & 1) << 5)); }
__host__ __device__ __forceinline__ void stage_rc(int b, int& R, int& C) { const int st = b / 1024, sb = b % 1024, swz = sb ^ (((sb >> 9) & 1) << 5); R = (st >> 1) * 16 + swz / 64; C = (st & 1) * 32 + (swz % 64) / 2; }
__host__ __device__ __forceinline__ int perm32(int rho) { const int n = rho >> 4, i = rho & 15; return 8 * (i >> 2) + 4 * n + (i & 3); }

struct Unit { int pm, pn; };
struct Gemm { const bf16_t* A; const bf16_t* Bt; int M, N, K; };

struct StaticOrder {
    int nM, nN, nwg, G, c;
    __host__ __device__ void init(int M, int N, int G_, int c_) { nM = M / BM; nN = N / BM; nwg = nM * nN; G = G_; c = c_; }
    __host__ __device__ __forceinline__ bool next(int i, Unit& u) const {
        const int L = i * G + c; if (L >= nwg) return false;
        int wgid = (int)L; { const int q = nwg / NXCD, r = nwg % NXCD, xcd = wgid % NXCD, off = wgid / NXCD; wgid = (xcd < r ? xcd * (q + 1) : r * (q + 1) + (xcd - r) * q) + off; }
        const int nig = WGM * nN, gid = wgid / nig, fm = gid * WGM, gsz = (nM - fm) < WGM ? (nM - fm) : WGM;
        u.pm = fm + ((wgid % nig) % gsz); u.pn = (wgid % nig) / gsz; return true;
    }
    __device__ __forceinline__ void a_ready(const Unit&) const {}
    __device__ __forceinline__ void done(const Unit&) const {}
};

__device__ __forceinline__ unsigned cvt_pk_bf16(float lo, float hi) { unsigned r; asm volatile("v_cvt_pk_bf16_f32 %0, %1, %2" : "=v"(r) : "v"(lo), "v"(hi)); return r; }
template <class Epi, class Sched, bool ALIGN_EPI = false, bool SP2 = false>
__device__ __forceinline__ void gemm_phase(PG8_LAS unsigned char* lds, const Gemm g, const Sched& S, const Epi& E) {
    int tid_ = threadIdx.x; asm volatile("" : "+v"(tid_));
    const int tid = tid_, wid = __builtin_amdgcn_readfirstlane(tid >> 6), lane = tid & 63, wr = wid >> 2, wc = wid & 3, fr = lane & 15, fq = lane >> 4;
    const int K = g.K, nt = K / BK;
    unsigned voffA[2], voffB[2];
#pragma unroll
    for (int i = 0; i < 2; ++i) { int R, C; stage_rc(tid * 16 + i * 8192, R, C); const int Rb = Epi::PERM ? ((R & ~31) + perm32(R & 31)) : R;
        voffA[i] = (unsigned)(R * K + C) * 2u; voffB[i] = (unsigned)(Rb * K + C) * 2u; }
    const size_t kstep = (size_t)(BK * 2);
    const size_t hstep = (size_t)HALF * K * 2;
    const size_t tstep = 2 * hstep;
    const unsigned ldsw = (unsigned)wid * 1024u;
    const int aoff = lds_byte(wr * 64 + fr, fq * 8), boff = lds_byte(wc * 32 + fr, fq * 8);
#define PG8_SA(b, h) (((b) * 2 + (h)) * HTB)
#define PG8_SB(b, h) ((4 + (b) * 2 + (h)) * HTB)
#define PG8_STAGE(bufoff, gbase, voff) do { _Pragma("unroll") for (int _i = 0; _i < 2; ++_i) \
        __builtin_amdgcn_global_load_lds((const unsigned*)((const char*)(gbase) + (voff)[_i]), (PG8_LAS unsigned*)(lds + (bufoff) + ldsw + _i * 8192), 16, 0, 0); } while (0)
#define PG8_LDA(dst, b, h) do { _Pragma("unroll") for (int m = 0; m < 4; ++m) _Pragma("unroll") for (int k = 0; k < 2; ++k) dst[m][k] = *(const PG8_LAS bf16x8*)(lds + PG8_SA(b, h) + aoff + m * 2048 + k * 1024); } while (0)
#define PG8_LDB(dst, b, h) do { _Pragma("unroll") for (int n = 0; n < 2; ++n) _Pragma("unroll") for (int k = 0; k < 2; ++k) dst[n][k] = *(const PG8_LAS bf16x8*)(lds + PG8_SB(b, h) + boff + n * 2048 + k * 1024); } while (0)
#define PG8_MMA(ai, bj, At, Bt) do { __builtin_amdgcn_s_setprio(1); _Pragma("unroll") for (int m = 0; m < 4; ++m) _Pragma("unroll") for (int n = 0; n < 2; ++n) _Pragma("unroll") for (int k = 0; k < 2; ++k) \
        acc[ai][bj][m][n] = __builtin_amdgcn_mfma_f32_16x16x32_bf16(Bt[n][k], At[m][k], acc[ai][bj][m][n], 0, 0, 0); __builtin_amdgcn_s_setprio(0); } while (0)
#define PG8_WAIT_V(n) asm volatile("s_waitcnt vmcnt(" #n ")" ::: "memory")
#define PG8_WAIT_L(n) asm volatile("s_waitcnt lgkmcnt(" #n ")" ::: "memory")
#define PG8_BAR __builtin_amdgcn_s_barrier()
#define PG8_SCHED __builtin_amdgcn_sched_barrier(0)
    Unit cur, nxt; int ui = 0;
    if (!S.next(0, cur)) return;
    typename Epi::State est;
    f32x4 acc[2][2][4][2];
#pragma unroll
    for (int a = 0; a < 2; ++a)
#pragma unroll
        for (int b = 0; b < 2; ++b)
#pragma unroll
            for (int m = 0; m < 4; ++m)
#pragma unroll
                for (int n = 0; n < 2; ++n) acc[a][b][m][n] = (f32x4){0.f, 0.f, 0.f, 0.f};
    bf16x8 At[4][2], B0[2][2], B1[2][2];
    const char* cA = (const char*)g.A + (size_t)cur.pm * tstep; const char* cB = (const char*)g.Bt + (size_t)cur.pn * tstep;
    S.a_ready(cur);
    if constexpr (SP2) {
        PG8_STAGE(PG8_SB(0, 0), cB, voffB); PG8_STAGE(PG8_SB(0, 1), cB + hstep, voffB); PG8_STAGE(PG8_SA(0, 0), cA, voffA); PG8_STAGE(PG8_SA(0, 1), cA + hstep, voffA);
        if (wr == 1) PG8_BAR;
        PG8_WAIT_V(2); PG8_BAR;
        PG8_STAGE(PG8_SB(1, 0), cB + kstep, voffB); PG8_STAGE(PG8_SA(1, 0), cA + kstep, voffA); PG8_STAGE(PG8_SB(1, 1), cB + hstep + kstep, voffB);
        PG8_WAIT_V(6); PG8_BAR;
    } else {
        PG8_STAGE(PG8_SB(0, 0), cB, voffB); PG8_STAGE(PG8_SA(0, 0), cA, voffA); PG8_STAGE(PG8_SB(0, 1), cB + hstep, voffB); PG8_STAGE(PG8_SA(0, 1), cA + hstep, voffA);
        if (wr == 1) PG8_BAR;
        PG8_WAIT_V(4); PG8_BAR;
        PG8_STAGE(PG8_SB(1, 0), cB + kstep, voffB); PG8_STAGE(PG8_SA(1, 0), cA + kstep, voffA); PG8_STAGE(PG8_SB(1, 1), cB + hstep + kstep, voffB);
        PG8_WAIT_V(6); PG8_BAR;
    }
    for (;;) {
        const bool has_next = S.next(ui + 1, nxt);
        const char* nA = has_next ? (const char*)g.A + (size_t)nxt.pm * tstep : cA; const char* nB = has_next ? (const char*)g.Bt + (size_t)nxt.pn * tstep : cB;
        for (int t = 0; t < nt; t += 2) {
            const bool last = (t == nt - 2);
            const char* a1 = cA + (size_t)(t + 1) * kstep;
            const char* a2 = last ? nA : cA + (size_t)(t + 2) * kstep; const char* b2 = last ? nB : cB + (size_t)(t + 2) * kstep;
            const char* a3 = a2 + kstep; const char* b3 = b2 + kstep;
            if (last && has_next) S.a_ready(nxt);
            if constexpr (SP2) {
            PG8_LDB(B0, 0, 0); PG8_LDB(B1, 0, 1); PG8_SCHED; PG8_LDA(At, 0, 0); PG8_STAGE(PG8_SA(1, 1), a1 + hstep, voffA);
            PG8_WAIT_V(8); PG8_WAIT_L(0); PG8_BAR; PG8_MMA(0, 0, At, B0); PG8_MMA(0, 1, At, B1); PG8_BAR; PG8_SCHED;
            PG8_LDA(At, 0, 1); PG8_STAGE(PG8_SB(0, 0), b2, voffB); PG8_STAGE(PG8_SB(0, 1), b2 + hstep, voffB); PG8_STAGE(PG8_SA(0, 0), a2, voffA);
            PG8_WAIT_V(8); PG8_WAIT_L(0); PG8_BAR; PG8_MMA(1, 0, At, B0); PG8_MMA(1, 1, At, B1); PG8_BAR; PG8_SCHED;
            PG8_LDB(B0, 1, 0); PG8_LDB(B1, 1, 1); PG8_SCHED; PG8_LDA(At, 1, 0); PG8_STAGE(PG8_SA(0, 1), a2 + hstep, voffA);
            PG8_WAIT_V(8); PG8_WAIT_L(0); PG8_BAR; PG8_MMA(0, 0, At, B0); PG8_MMA(0, 1, At, B1); PG8_BAR; PG8_SCHED;
            PG8_LDA(At, 1, 1); PG8_STAGE(PG8_SB(1, 0), b3, voffB); PG8_STAGE(PG8_SB(1, 1), b3 + hstep, voffB); PG8_STAGE(PG8_SA(1, 0), a3, voffA);
            PG8_WAIT_V(8); PG8_WAIT_L(0); PG8_BAR; PG8_MMA(1, 0, At, B0); PG8_MMA(1, 1, At, B1); PG8_BAR; PG8_SCHED;
            } else {
            PG8_LDB(B0, 0, 0); PG8_SCHED; PG8_LDA(At, 0, 0); PG8_STAGE(PG8_SA(1, 1), a1 + hstep, voffA);
            PG8_WAIT_L(8); PG8_BAR; PG8_WAIT_L(0); PG8_MMA(0, 0, At, B0); PG8_BAR; PG8_SCHED;
            PG8_LDB(B1, 0, 1); PG8_STAGE(PG8_SB(0, 0), b2, voffB);
            PG8_BAR; PG8_WAIT_L(0); PG8_MMA(0, 1, At, B1); PG8_BAR;
            PG8_LDA(At, 0, 1); PG8_STAGE(PG8_SA(0, 0), a2, voffA);
            PG8_BAR; PG8_WAIT_L(0); PG8_MMA(1, 0, At, B0); PG8_BAR; PG8_SCHED;
            PG8_STAGE(PG8_SB(0, 1), b2 + hstep, voffB);
            PG8_WAIT_V(6); PG8_BAR; PG8_MMA(1, 1, At, B1); PG8_BAR;
            PG8_LDB(B0, 1, 0); PG8_SCHED; PG8_LDA(At, 1, 0); PG8_STAGE(PG8_SA(0, 1), a2 + hstep, voffA);
            PG8_WAIT_L(8); PG8_BAR; PG8_WAIT_L(0); PG8_MMA(0, 0, At, B0); PG8_BAR; PG8_SCHED;
            PG8_LDB(B1, 1, 1); PG8_STAGE(PG8_SB(1, 0), b3, voffB);
            PG8_BAR; PG8_WAIT_L(0); PG8_MMA(0, 1, At, B1); PG8_BAR;
            PG8_LDA(At, 1, 1); PG8_STAGE(PG8_SA(1, 0), a3, voffA);
            PG8_BAR; PG8_WAIT_L(0); PG8_MMA(1, 0, At, B0); PG8_BAR; PG8_SCHED;
            PG8_STAGE(PG8_SB(1, 1), b3 + hstep, voffB);
            PG8_WAIT_V(6); PG8_BAR; PG8_MMA(1, 1, At, B1); PG8_BAR;
            }
        }
        if constexpr (ALIGN_EPI) { if (wr == 0) PG8_BAR; }
        if constexpr (!Epi::AFTER_DRAIN) { E(acc, cur, wr, wc, fr, fq, est); S.done(cur); }
        if (!has_next) break;
#pragma unroll
        for (int a = 0; a < 2; ++a)
#pragma unroll
            for (int b = 0; b < 2; ++b)
#pragma unroll
                for (int m = 0; m < 4; ++m)
#pragma unroll
                    for (int n = 0; n < 2; ++n) acc[a][b][m][n] = (f32x4){0.f, 0.f, 0.f, 0.f};
        cur = nxt; cA = nA; cB = nB; ++ui;
        if constexpr (ALIGN_EPI) { if (wr == 1) PG8_BAR; }
    }
    PG8_WAIT_V(0);
    if constexpr (!ALIGN_EPI) { if (wr == 0) PG8_BAR; }
    PG8_BAR;
    if constexpr (Epi::AFTER_DRAIN) { E.fused(acc, cur, wr, wc, fr, fq, lds, wid, lane); S.done(cur); }
#undef PG8_SA
#undef PG8_SB
#undef PG8_STAGE
#undef PG8_LDA
#undef PG8_LDB
#undef PG8_MMA
#undef PG8_WAIT_V
#undef PG8_WAIT_L
#undef PG8_BAR
#undef PG8_SCHED
}
}

#define LAS __attribute__((address_space(3)))
typedef unsigned short bf16_t;
using pg8::bf16x8; using pg8::f32x4; using pg8::u32x4;
typedef unsigned u32x2 __attribute__((ext_vector_type(2)));
typedef short bf16x4 __attribute__((ext_vector_type(4)));

constexpr int NB = 4, T = 8192, D = 1024, M = NB * T, DEPTH = 4, NMEM = 256, MM = NB * NMEM;
constexpr int DIN = 2560, FF = 2816;
constexpr float EPS = 1e-6f, LOG2E = 1.4426950408889634f;
constexpr size_t MiB = 1u << 20;
constexpr size_t WS_CTL = 0, CTL_BYTES = 1 * MiB;
constexpr size_t WS_LB = 1 * MiB, WS_PART = 2 * MiB, WS_DBUF = 4 * MiB, WS_POOLT = 5 * MiB, WS_MEMN = 6 * MiB, WS_KB = 14 * MiB, WS_VTB = 22 * MiB, WS_WKV = 30 * MiB;
constexpr size_t WS_W13A = 46 * MiB, WS_W2A = 57 * MiB, WS_W13B = 63 * MiB, WS_W2B = 74 * MiB, WS_WIN = 80 * MiB, WS_WOUT = 85 * MiB, WS_WQ = 87 * MiB, WS_WO = 89 * MiB;
constexpr size_t WS_XB = 92 * MiB, WS_R1 = 156 * MiB, WS_SBUF = 332 * MiB, WS_OCAT = 396 * MiB, WS_XLO = 460 * MiB, WS_END = 492 * MiB;
constexpr int LDS_BYTES = 155648;
constexpr int NPHASE = 2 + 12 * DEPTH + (DEPTH - 1) + 1 - DEPTH;

struct Args { const float* in[23]; float* out; unsigned char* ws; int ph_lo, ph_hi; };

__device__ __forceinline__ float bf2f(unsigned b) { return __uint_as_float(b << 16); }
typedef float f32x2_t __attribute__((ext_vector_type(2))); typedef __bf16 bf16x2_t __attribute__((ext_vector_type(2)));
__device__ __forceinline__ unsigned pk2(float lo, float hi) { f32x2_t v = {lo, hi}; bf16x2_t b = __builtin_convertvector(v, bf16x2_t); return __builtin_bit_cast(unsigned, b); }
__device__ __forceinline__ float wave_sum(float v) {
#pragma unroll
    for (int o = 1; o < 64; o <<= 1) v += __shfl_xor(v, o);
    return v;
}
__device__ __forceinline__ float row_rstd(const float* part, int r) {
    const f32x4* p = (const f32x4*)(part + (size_t)r * 16);
    const f32x4 a = p[0], b = p[1], c = p[2], d = p[3];
    const float s = ((a.x + a.y) + (a.z + a.w)) + ((b.x + b.y) + (b.z + b.w)) + ((c.x + c.y) + (c.z + c.w)) + ((d.x + d.y) + (d.z + d.w));
    return rsqrtf(s * (1.f / 1024.f) + EPS);
}
#define LBAR() do { asm volatile("s_waitcnt lgkmcnt(0)" ::: "memory"); __builtin_amdgcn_s_barrier(); asm volatile("" ::: "memory"); } while (0)
__device__ __forceinline__ float silu_f(float x) { return x * __builtin_amdgcn_rcpf(1.f + __builtin_amdgcn_exp2f(-x * LOG2E)); }

__device__ __forceinline__ void rstd8(const float* part, int rowU0, int fr, int fq, float (&rs)[8]) {
    const unsigned vo = (unsigned)(fr * 16 + fq * 4);
#pragma unroll
    for (int i = 0; i < 8; ++i) { const float* pb = part + (size_t)(rowU0 + (i >> 2) * 128 + (i & 3) * 16) * 16; const f32x4 p = *(const f32x4*)(pb + vo); rs[i] = (p.x + p.y) + (p.z + p.w); }
#pragma unroll
    for (int i = 0; i < 8; ++i) { float s = rs[i]; s += __shfl_xor(s, 16); s += __shfl_xor(s, 32); rs[i] = rsqrtf(s * (1.f / 1024.f) + EPS); }
}
__device__ __forceinline__ void rs_cached(const float* part, LAS unsigned char* L, int rowU0, int wr, int wc, int fr, int fq, bool fresh, float (&rs)[8]) {
    LAS f32x4* slot = (LAS f32x4*)(L + 131072) + (((wr * 4 + wc) * 64 + fq * 16 + fr) * 2);
    if (fresh) { rstd8(part, rowU0, fr, fq, rs); slot[0] = (f32x4){rs[0], rs[1], rs[2], rs[3]}; slot[1] = (f32x4){rs[4], rs[5], rs[6], rs[7]}; }
    else { const f32x4 a = slot[0], b = slot[1]; rs[0] = a[0]; rs[1] = a[1]; rs[2] = a[2]; rs[3] = a[3]; rs[4] = b[0]; rs[5] = b[1]; rs[6] = b[2]; rs[7] = b[3]; }
}
template <bool SCALE> struct EpiScale {
    static constexpr bool PERM = true, AFTER_DRAIN = false;
    bf16_t* O; int ldc; const float* part; LAS unsigned char* L;
    struct State { int pm = -1; };
    __device__ __forceinline__ void operator()(const f32x4 (&acc)[2][2][4][2], const pg8::Unit& u, int wr, int wc, int fr, int fq, State& st) const {
        const int rowU0 = u.pm * 256 + wr * 64; const unsigned vo = (unsigned)(fr * ldc + wc * 32 + 8 * fq);
        float rs[8];
        if (SCALE) rs_cached(part, L, rowU0, wr, wc, fr, fq, st.pm != u.pm, rs);
        st.pm = u.pm;
#pragma unroll
        for (int ai = 0; ai < 2; ++ai)
#pragma unroll
            for (int m = 0; m < 4; ++m) { const float r_ = SCALE ? rs[ai * 4 + m] : 1.f;
                bf16_t* rowp = O + (size_t)(rowU0 + ai * 128 + m * 16) * ldc + u.pn * 256;
#pragma unroll
                for (int bj = 0; bj < 2; ++bj) { const f32x4 v0 = acc[ai][bj][m][0] * r_, v1 = acc[ai][bj][m][1] * r_;
                    u32x4 w; w.x = pk2(v0[0], v0[1]); w.y = pk2(v0[2], v0[3]); w.z = pk2(v1[0], v1[1]); w.w = pk2(v1[2], v1[3]);
                    *(u32x4*)(rowp + (vo + bj * 128)) = w; } }
    }
};
struct EpiSwiglu {
    static constexpr bool PERM = true, AFTER_DRAIN = false;
    bf16_t* G; const float* part; LAS unsigned char* L;
    struct State { int pm = -1; };
    __device__ __forceinline__ void operator()(const f32x4 (&acc)[2][2][4][2], const pg8::Unit& u, int wr, int wc, int fr, int fq, State& st) const {
        const int rowU0 = u.pm * 256 + wr * 64; const unsigned vo = (unsigned)(fr * FF + wc * 32 + 8 * fq);
        float rs[8];
        rs_cached(part, L, rowU0, wr, wc, fr, fq, st.pm != u.pm, rs);
        st.pm = u.pm;
#pragma unroll
        for (int ai = 0; ai < 2; ++ai)
#pragma unroll
            for (int m = 0; m < 4; ++m) { const float r_ = rs[ai * 4 + m], c_ = -r_ * LOG2E, r2_ = r_ * r_;
                f32x2_t g2[4];
#pragma unroll
                for (int n = 0; n < 2; ++n)
#pragma unroll
                    for (int jp = 0; jp < 2; ++jp) { const f32x2_t a1 = {acc[ai][0][m][n][2 * jp], acc[ai][0][m][n][2 * jp + 1]}, a3 = {acc[ai][1][m][n][2 * jp], acc[ai][1][m][n][2 * jp + 1]};
                        const f32x2_t t = a1 * c_; f32x2_t e; e.x = __builtin_amdgcn_exp2f(t.x); e.y = __builtin_amdgcn_exp2f(t.y);
                        const f32x2_t d = e + 1.f; f32x2_t q; q.x = __builtin_amdgcn_rcpf(d.x); q.y = __builtin_amdgcn_rcpf(d.y);
                        g2[n * 2 + jp] = ((a1 * a3) * r2_) * q; }
                u32x4 w; w.x = pk2(g2[0].x, g2[0].y); w.y = pk2(g2[1].x, g2[1].y); w.z = pk2(g2[2].x, g2[2].y); w.w = pk2(g2[3].x, g2[3].y);
                bf16_t* rowp = G + (size_t)(rowU0 + ai * 128 + m * 16) * FF + u.pn * 128;
                *(u32x4*)(rowp + vo) = w; }
    }
};
struct EpiResid {
    static constexpr bool PERM = true, AFTER_DRAIN = false;
    bf16_t* XB; float* part; float scale;
    struct State {};
    __device__ __forceinline__ void operator()(const f32x4 (&acc)[2][2][4][2], const pg8::Unit& u, int wr, int wc, int fr, int fq, State&) const {
        const int rowU0 = u.pm * 256 + wr * 64; const unsigned vo = (unsigned)(fr * D + wc * 32 + 8 * fq), vp = (unsigned)(fr * 16);
        u32x4 xv[2][4][2];
#pragma unroll
        for (int ai = 0; ai < 2; ++ai)
#pragma unroll
            for (int m = 0; m < 4; ++m) { const bf16_t* brow = XB + (size_t)(rowU0 + ai * 128 + m * 16) * D + u.pn * 256;
#pragma unroll
                for (int bj = 0; bj < 2; ++bj) xv[ai][m][bj] = *(const u32x4*)(brow + (vo + bj * 128)); }
#pragma unroll
        for (int ai = 0; ai < 2; ++ai)
#pragma unroll
            for (int m = 0; m < 4; ++m) { const size_t rU = (size_t)(rowU0 + ai * 128 + m * 16); float ss = 0.f;
                bf16_t* brow = XB + rU * D + u.pn * 256;
#pragma unroll
                for (int bj = 0; bj < 2; ++bj) { const u32x4 xr = xv[ai][m][bj]; u32x4 w;
#pragma unroll
                    for (int q = 0; q < 4; ++q) { const f32x4& av = acc[ai][bj][m][q >> 1];
                        const float lo = bf2f(xr[q] & 0xffffu) + av[(q & 1) * 2] * scale, hi = __uint_as_float(xr[q] & 0xffff0000u) + av[(q & 1) * 2 + 1] * scale;
                        w[q] = pk2(lo, hi);
                        const float rl = bf2f(w[q] & 0xffffu), rh = __uint_as_float(w[q] & 0xffff0000u); ss += rl * rl + rh * rh; }
                    *(u32x4*)(brow + (vo + bj * 128)) = w; }
                ss += __shfl_xor(ss, 16); ss += __shfl_xor(ss, 32);
                float* pp = part + rU * 16 + u.pn * 4 + wc;
                if (fq == 0) pp[vp] = ss; }
    }
};
struct SingleUnit { int pm, pn;
    __device__ __forceinline__ bool next(int i, pg8::Unit& u) const { if (i) return false; u.pm = pm; u.pn = pn; return true; }
    __device__ __forceinline__ void a_ready(const pg8::Unit&) const {}
    __device__ __forceinline__ void done(const pg8::Unit&) const {}
};

__device__ __forceinline__ void tr_item(const float* W, int ldw, int col0, int k0, const float* gain, float scale, bf16_t* dst, int ldd, int drow0, LAS float* scr, int lane) {
#pragma unroll 8
    for (int i = 0; i < 32; ++i) { const int kk = 2 * i + (lane >> 5); const float g = gain ? gain[k0 + kk] * scale : scale;
        scr[kk * 33 + (lane & 31)] = W[(size_t)(k0 + kk) * ldw + col0 + (lane & 31)] * g; }
    asm volatile("s_waitcnt lgkmcnt(0)" ::: "memory");
    const int c = lane & 7;
#pragma unroll
    for (int j = 0; j < 4; ++j) { const int n = (lane >> 3) + 8 * j; const LAS float* s = scr + (8 * c) * 33 + n;
        u32x4 o; o.x = pk2(s[0 * 33], s[1 * 33]); o.y = pk2(s[2 * 33], s[3 * 33]); o.z = pk2(s[4 * 33], s[5 * 33]); o.w = pk2(s[6 * 33], s[7 * 33]);
        *(u32x4*)(dst + (size_t)(drow0 + n) * ldd + k0 + 8 * c) = o; }
    asm volatile("s_waitcnt lgkmcnt(0)" ::: "memory");
}
__device__ __forceinline__ void conv_layer(const Args& a, int l, LAS float* scr, int gw, int NGW, int lane) {
    unsigned char* ws = a.ws;
    constexpr int I13 = 176 * 16, I2 = 32 * 44, IIN = 80 * 16, ISQ = 32 * 16, IPOOL = 32;
    constexpr int NIT = 2 * I13 + 2 * I2 + IIN + 3 * ISQ + IPOOL;
    for (int it = gw; it < NIT; it += NGW) {
        int r = it;
        if (r < 2 * I13) { const int second = r >= I13; if (second) r -= I13;
            const int rb = r >> 4, kb = r & 15, r0 = rb * 32, pn = r0 >> 8, within = r0 & 255;
            const float* src = (within < 128 ? a.in[second ? 19 : 3] : a.in[second ? 20 : 4]) + (size_t)l * D * FF;
            tr_item(src, FF, pn * 128 + (within & 127), kb * 64, a.in[second ? 18 : 2] + l * D, 1.f, (bf16_t*)(ws + (second ? WS_W13B : WS_W13A)), D, r0, scr, lane); continue; }
        r -= 2 * I13;
        if (r < 2 * I2) { const int second = r >= I2; if (second) r -= I2;
            const int rb = r / 44, kb = r % 44;
            tr_item(a.in[second ? 21 : 5] + (size_t)l * FF * D, D, rb * 32, kb * 64, nullptr, 1.f, (bf16_t*)(ws + (second ? WS_W2B : WS_W2A)), FF, rb * 32, scr, lane); continue; }
        r -= 2 * I2;
        if (r < IIN) { const int rb = r >> 4, kb = r & 15;
            tr_item(a.in[7] + (size_t)l * D * DIN, DIN, rb * 32, kb * 64, a.in[6] + l * D, 1.f, (bf16_t*)(ws + WS_WIN), D, rb * 32, scr, lane); continue; }
        r -= IIN;
        if (r < 3 * ISQ) { const int which = r / ISQ; r -= which * ISQ; const int rb = r >> 4, kb = r & 15;
            const float* src = a.in[which == 0 ? 12 : (which == 1 ? 15 : 17)] + (size_t)l * D * D;
            tr_item(src, D, rb * 32, kb * 64, which == 1 ? a.in[13] + l * D : nullptr, which == 1 ? 0.0625f : 1.f, (bf16_t*)(ws + (which == 0 ? WS_WOUT : (which == 1 ? WS_WQ : WS_WO))), D, rb * 32, scr, lane); continue; }
        r -= 3 * ISQ;
        { const int g = r >> 3, rr = r & 7, kb = rr & 1, rb = rr >> 1;
            tr_item(a.in[10] + (size_t)(l * 4 + g) * 128 * 128, 128, rb * 32, kb * 64, nullptr, 1.f, (bf16_t*)(ws + WS_POOLT) + g * 16384, 128, rb * 32, scr, lane); }
    }
}

__device__ __forceinline__ void p0_prologue(const Args& a, LAS unsigned char* L, int vcu, int G, int tid, int wave, int lane) {
    unsigned char* ws = a.ws;
    const int gw = vcu * 8 + wave, NGW = G * 8;
    LAS float* scr = (LAS float*)(L + wave * 16384);
    { const float* x = a.in[0]; bf16_t* XB = (bf16_t*)(ws + WS_XB); float* part = (float*)(ws + WS_PART);
      for (int m = gw; m < M; m += NGW) {
          const f32x4* xr = (const f32x4*)(x + (size_t)m * D) + lane;
          unsigned long long* o8 = (unsigned long long*)(XB + (size_t)m * D) + lane;
          float s = 0.f;
#pragma unroll
          for (int j = 0; j < 4; ++j) { const f32x4 v = xr[64 * j]; const unsigned w0 = pk2(v.x, v.y), w1 = pk2(v.z, v.w);
              const float r0 = bf2f(w0 & 0xffffu), r1 = __uint_as_float(w0 & 0xffff0000u), r2 = bf2f(w1 & 0xffffu), r3 = __uint_as_float(w1 & 0xffff0000u); s += (r0 * r0 + r1 * r1) + (r2 * r2 + r3 * r3);
              o8[64 * j] = (unsigned long long)w0 | ((unsigned long long)w1 << 32);
              }
          s = wave_sum(s);
          if (lane < 16) part[(size_t)m * 16 + lane] = lane == 0 ? s : 0.f;
      } }
    { const float* mem = a.in[1]; bf16_t* MN = (bf16_t*)(ws + WS_MEMN);
      for (int m = gw; m < MM; m += NGW) {
          const f32x4* xr = (const f32x4*)(mem + (size_t)m * D) + lane; f32x4 v[4]; float s = 0.f;
#pragma unroll
          for (int j = 0; j < 4; ++j) { v[j] = xr[64 * j]; s += (v[j].x * v[j].x + v[j].y * v[j].y) + (v[j].z * v[j].z + v[j].w * v[j].w); }
          const float rs = rsqrtf(wave_sum(s) * (1.f / 1024.f) + EPS);
          for (int l = 0; l < DEPTH; ++l) { const f32x4* g = (const f32x4*)(a.in[14] + l * D) + lane;
              unsigned long long* o8 = (unsigned long long*)(MN + ((size_t)l * MM + m) * D) + lane;
#pragma unroll
              for (int j = 0; j < 4; ++j) { const f32x4 gg = g[64 * j]; const f32x4 y = v[j] * rs * gg;
                  o8[64 * j] = (unsigned long long)pk2(y.x, y.y) | ((unsigned long long)pk2(y.z, y.w) << 32); } }
      } }
    if (vcu == 0) { float* LB = (float*)(ws + WS_LB); const float* lg = a.in[8];
        const float e0 = lg[tid], e1 = lg[512 + tid], e2 = lg[1024 + tid], e3 = lg[1536 + tid];
        const float mx = fmaxf(fmaxf(e0, e1), fmaxf(e2, e3));
        const float p0 = __expf(e0 - mx), p1 = __expf(e1 - mx), p2 = __expf(e2 - mx), p3 = __expf(e3 - mx), inv = 1.f / (p0 + p1 + p2 + p3);
        LB[tid] = 0.f; LB[512 + tid] = p1 * inv; LB[1024 + tid] = (p1 + p2) * inv; LB[1536 + tid] = (p1 + p2 + p3) * inv; }
    for (int it = gw; it < 4096; it += NGW) { const int l = it >> 10, rr = it & 1023, rb = rr >> 4, kb = rr & 15;
        tr_item(a.in[16] + (size_t)l * D * 2048, 2048, rb * 32, kb * 64, nullptr, 1.f, (bf16_t*)(ws + WS_WKV) + (size_t)l * 2048 * D, D, rb * 32, scr, lane); }
    conv_layer(a, 0, scr, gw, NGW, lane);
}

__device__ __forceinline__ void e_pair_load(const bf16_t* P, int u, int pu, int tid, unsigned (&zr)[16], unsigned (&vr)[16], unsigned (&ur)[20]) {
    const int col = tid & 127, sg = tid >> 7;
    const int h = u & 3, c = (u >> 2) & 127, b = u >> 9, t0 = b * T + c * 64;
    const int g = pu & 3, tile = pu >> 2, pt0 = tile * 64, tpos0 = pt0 & (T - 1);
    const bf16_t* pz = P + (size_t)(t0 + 16 * sg) * DIN + 512 + h * 128 + col;
#pragma unroll
    for (int i = 0; i < 16; ++i) { zr[i] = pz[(size_t)i * DIN]; vr[i] = pz[(size_t)i * DIN + 512]; }
    const bf16_t* pu_ = P + 2048 + g * 128 + col;
#pragma unroll
    for (int j = 0; j < 20; ++j) { const int r = sg + 4 * j, tp = tpos0 - 15 + r; ur[j] = (r < 79 && tp >= 0) ? (unsigned)pu_[(size_t)(pt0 - 15 + r) * DIN] : 0u; }
}
__device__ __forceinline__ void e_unit_pair(LAS unsigned char* L, const float* LBl, bf16_t* SB, float* DB, const bf16_t* PT, const float* pscale, bf16_t* OC,
                                            int u, int pu, int tid, int wave, int lane, const unsigned (&zr)[16], const unsigned (&vr)[16], const unsigned (&ur)[20]) {
    int col = tid & 127, sg = tid >> 7, fr = lane & 15, fq = lane >> 4;
#define E_RELANE() do { int t_ = tid; asm volatile("" : "+v"(t_)); col = t_ & 127; sg = t_ >> 7; fr = t_ & 15; fq = (t_ >> 4) & 3; } while (0)
    const int h = u & 3, c = (u >> 2) & 127, b = u >> 9, t0 = b * T + c * 64, sidx = (b * 4 + h) * 128 + c;
    LAS float* tot = (LAS float*)L;
    LAS bf16_t* kT = (LAS bf16_t*)(L + 2048);
    LAS bf16_t* vT = (LAS bf16_t*)(L + 2048 + 128 * 144);
    const int g = pu & 3, tile = pu >> 2, pt0 = tile * 64, tpos0 = pt0 & (T - 1);
    LAS float* uL = (LAS float*)(L + 40960);
    LAS bf16_t* pL = (LAS bf16_t*)(L + 40960 + 79 * 128 * 4);
    const float lb = LBl[h * 128 + col], oml = 1.f - lb;
    float kk[16], cs[16]; float run = 0.f;
#pragma unroll
    for (int i = 0; i < 16; ++i) { float z = bf2f(zr[i]); z = fminf(fmaxf(z, -30.f), 30.f);
        const float sig = __builtin_amdgcn_rcpf(1.f + __builtin_amdgcn_exp2f(-z * LOG2E)), f = lb + oml * sig;
        run += __builtin_amdgcn_logf(f); cs[i] = run; kk[i] = 1.f - f; }
    tot[sg * 128 + col] = run;
#pragma unroll
    for (int j = 0; j < 20; ++j) { const int r = sg + 4 * j; if (r < 79) uL[r * 128 + col] = bf2f(ur[j]); }
    LBAR(); E_RELANE();
    { float pre = 0.f, btot = 0.f;
#pragma unroll
      for (int j = 0; j < 4; ++j) { const float tj = tot[j * 128 + col]; btot += tj; if (j < sg) pre += tj; }
      unsigned wk[8], wv[8];
#pragma unroll
      for (int i = 0; i < 8; ++i) { const float e0 = __builtin_amdgcn_exp2f(btot - (pre + cs[2 * i])), e1 = __builtin_amdgcn_exp2f(btot - (pre + cs[2 * i + 1]));
          wk[i] = pk2(kk[2 * i] * e0, kk[2 * i + 1] * e1); wv[i] = vr[2 * i] | (vr[2 * i + 1] << 16); }
      *(LAS u32x4*)(kT + col * 72 + 16 * sg) = (u32x4){wk[0], wk[1], wk[2], wk[3]}; *(LAS u32x4*)(kT + col * 72 + 16 * sg + 8) = (u32x4){wk[4], wk[5], wk[6], wk[7]};
      *(LAS u32x4*)(vT + col * 72 + 16 * sg) = (u32x4){wv[0], wv[1], wv[2], wv[3]}; *(LAS u32x4*)(vT + col * 72 + 16 * sg + 8) = (u32x4){wv[4], wv[5], wv[6], wv[7]};
      if (sg == 0) DB[(size_t)sidx * 128 + col] = __builtin_amdgcn_exp2f(btot); }
    { const int w = 2 << g, s0 = 16 * sg; float sum = 0.f;
      for (int j = 1; j < w; ++j) sum += uL[(15 + s0 - j) * 128 + col];
#pragma unroll
      for (int i = 0; i < 16; ++i) { const int s = s0 + i; const float cur = uL[(15 + s) * 128 + col]; sum += cur;
          const int cnt = min(tpos0 + s + 1, w);
          const float p = sum * __builtin_amdgcn_rcpf((float)cnt) - cur;
          pL[s * 136 + col] = (bf16_t)(pk2(p, 0.f) & 0xffffu);
          sum -= uL[(16 + s - w) * 128 + col]; } }
    LBAR(); E_RELANE();
    const int tb = wave >> 1, dh = wave & 1;
    const bf16_t* wt = PT + g * 16384;
    bf16x8 wfr[4][4]; f32x4 scv[4];
#pragma unroll
    for (int nt = 0; nt < 4; ++nt) { const int d0 = 64 * dh + 16 * nt;
#pragma unroll
        for (int k = 0; k < 4; ++k) wfr[nt][k] = *(const bf16x8*)(wt + (d0 + fr) * 128 + 32 * k + 8 * fq);
        scv[nt] = *(const f32x4*)(pscale + g * 128 + d0 + 4 * fq); }
    { const bf16x8 a0 = *(const LAS bf16x8*)(kT + (16 * wave + fr) * 72 + 8 * fq), a1 = *(const LAS bf16x8*)(kT + (16 * wave + fr) * 72 + 32 + 8 * fq);
      bf16_t* ut = SB + (size_t)sidx * 16384;
#pragma unroll
      for (int nt = 0; nt < 8; ++nt) {
          const bf16x8 b0 = *(const LAS bf16x8*)(vT + (16 * nt + fr) * 72 + 8 * fq), b1 = *(const LAS bf16x8*)(vT + (16 * nt + fr) * 72 + 32 + 8 * fq);
          f32x4 acc = {0.f, 0.f, 0.f, 0.f};
          acc = __builtin_amdgcn_mfma_f32_16x16x32_bf16(a0, b0, acc, 0, 0, 0);
          acc = __builtin_amdgcn_mfma_f32_16x16x32_bf16(a1, b1, acc, 0, 0, 0);
          *(u32x2*)(ut + (16 * nt + fr) * 128 + 16 * wave + 4 * fq) = (u32x2){pk2(acc[0], acc[1]), pk2(acc[2], acc[3])};
      } }
    { bf16x8 pf[4];
#pragma unroll
      for (int k = 0; k < 4; ++k) pf[k] = *(const LAS bf16x8*)(pL + (16 * tb + fr) * 136 + 32 * k + 8 * fq);
#pragma unroll
      for (int nt = 0; nt < 4; ++nt) { const int d0 = 64 * dh + 16 * nt; f32x4 acc = {0.f, 0.f, 0.f, 0.f};
#pragma unroll
          for (int k = 0; k < 4; ++k) acc = __builtin_amdgcn_mfma_f32_16x16x32_bf16(wfr[nt][k], pf[k], acc, 0, 0, 0);
          const f32x4 sc = scv[nt];
          *(u32x2*)(OC + (size_t)(pt0 + 16 * tb + fr) * D + 512 + g * 128 + d0 + 4 * fq) = (u32x2){pk2(acc[0] * sc[0], acc[1] * sc[1]), pk2(acc[2] * sc[2], acc[3] * sc[3])};
      } }
}
#undef E_RELANE

__device__ __forceinline__ void hgrn_scan(bf16_t* SB, const float* DB, int vcu, int G, int tid) {
    for (int e = vcu * 512 + tid; e < 16 * 8192; e += G * 512) {
        const int bh = e >> 13, pi = e & 8191;
        unsigned* sp = (unsigned*)(SB + (size_t)bh * 128 * 16384) + pi;
        const float* dp = DB + (size_t)bh * 128 * 128 + 2 * (pi & 63);
        float s0 = 0.f, s1 = 0.f;
        for (int c0 = 0; c0 < 128; c0 += 16) {
            unsigned uu[16]; float d0[16], d1[16];
#pragma unroll
            for (int i = 0; i < 16; ++i) { uu[i] = sp[(size_t)(c0 + i) * 8192]; const float2 dd = *(const float2*)(dp + (c0 + i) * 128); d0[i] = dd.x; d1[i] = dd.y; }
#pragma unroll
            for (int i = 0; i < 16; ++i) { sp[(size_t)(c0 + i) * 8192] = pk2(s0, s1);
                s0 = d0[i] * s0 + bf2f(uu[i] & 0xffffu); s1 = d1[i] * s1 + __uint_as_float(uu[i] & 0xffff0000u); }
        }
    }
}

constexpr int HOUT_LDS = 75776;
__device__ __forceinline__ void hgrn_out_pair(LAS unsigned char* L0, const bf16_t* P, const float* LBl, const bf16_t* SB, const float* hg, bf16_t* OC, int uA, int uB, int tid, int wave, int lane) {
    int col = tid & 127, sg = tid >> 7, fr = lane & 15, fq = lane >> 4; const int tb = wave >> 1, vh = wave & 1, sb = wave & 1;
#define HOUT_RELANE() do { int t_ = tid; asm volatile("" : "+v"(t_)); col = t_ & 127; sg = t_ >> 7; fr = t_ & 15; fq = (t_ >> 4) & 3; } while (0)
    int h[2], t0[2], sidx[2];
    float kk[2][16], cs[2][16], qv[2][16]; unsigned vr[2][16];
#pragma unroll
    for (int p = 0; p < 2; ++p) { const int u = p ? uB : uA; h[p] = u & 3; const int c = (u >> 2) & 127, b = u >> 9; t0[p] = b * T + c * 64; sidx[p] = (b * 4 + h[p]) * 128 + c; }
    unsigned qr[2][16], zr[2][16];
#pragma unroll
    for (int p = 0; p < 2; ++p) { const bf16_t* pq = P + (size_t)(t0[p] + 16 * sg) * DIN + h[p] * 128 + col;
#pragma unroll
        for (int i = 0; i < 16; ++i) { qr[p][i] = pq[(size_t)i * DIN]; zr[p][i] = pq[(size_t)i * DIN + 512]; vr[p][i] = pq[(size_t)i * DIN + 1024]; } }
#pragma unroll
    for (int p = 0; p < 2; ++p) { LAS float* tot = (LAS float*)(L0 + p * HOUT_LDS);
        const float lb = LBl[h[p] * 128 + col], oml = 1.f - lb; float run = 0.f;
#pragma unroll
        for (int i = 0; i < 16; ++i) { float z = bf2f(zr[p][i]); z = fminf(fmaxf(z, -30.f), 30.f);
            const float sig = __builtin_amdgcn_rcpf(1.f + __builtin_amdgcn_exp2f(-z * LOG2E)), f = lb + oml * sig;
            run += __builtin_amdgcn_logf(f); cs[p][i] = run; kk[p][i] = 1.f - f; qv[p][i] = bf2f(qr[p][i]); }
        tot[sg * 128 + col] = run; }
    LBAR(); HOUT_RELANE();
#pragma unroll
    for (int p = 0; p < 2; ++p) { LAS unsigned char* L = L0 + p * HOUT_LDS;
        LAS float* tot = (LAS float*)L; LAS bf16_t* qh = (LAS bf16_t*)(L + 4096); LAS bf16_t* k0L = (LAS bf16_t*)(L + 4096 + 17408); LAS bf16_t* q1L = (LAS bf16_t*)(L + 4096 + 26112);
        LAS bf16_t* k1L = (LAS bf16_t*)(L + 4096 + 34816); LAS bf16_t* vT = (LAS bf16_t*)(L + 4096 + 43520);
        float pre = 0.f;
#pragma unroll
        for (int j = 0; j < 4; ++j) { const float tj = tot[j * 128 + col]; if (j < sg) pre += tj; }
        const float b31 = tot[col] + tot[128 + col];
#pragma unroll
        for (int i = 0; i < 16; ++i) { const int s = 16 * sg + i; const float bb = pre + cs[p][i];
            qh[s * 136 + col] = (bf16_t)(pk2(qv[p][i] * __builtin_amdgcn_exp2f(bb), 0.f) & 0xffffu);
            if (sg < 2) { k0L[s * 136 + col] = (bf16_t)(pk2(kk[p][i] * __builtin_amdgcn_exp2f(fminf(-bb, 115.f)), 0.f) & 0xffffu); }
            else { q1L[(s - 32) * 136 + col] = (bf16_t)(pk2(qv[p][i] * __builtin_amdgcn_exp2f(bb - b31), 0.f) & 0xffffu);
                   k1L[(s - 32) * 136 + col] = (bf16_t)(pk2(kk[p][i] * __builtin_amdgcn_exp2f(fminf(b31 - bb, 115.f)), 0.f) & 0xffffu); } }
        unsigned wv[8];
#pragma unroll
        for (int i = 0; i < 8; ++i) wv[i] = vr[p][2 * i] | (vr[p][2 * i + 1] << 16);
        *(LAS u32x4*)(vT + col * 72 + 16 * sg) = (u32x4){wv[0], wv[1], wv[2], wv[3]}; *(LAS u32x4*)(vT + col * 72 + 16 * sg + 8) = (u32x4){wv[4], wv[5], wv[6], wv[7]}; }
    HOUT_RELANE();
    bf16x8 sfr[2][4][4];
#pragma unroll
    for (int p = 0; p < 2; ++p) { const bf16_t* st = SB + (size_t)sidx[p] * 16384;
#pragma unroll
        for (int nt = 0; nt < 4; ++nt)
#pragma unroll
            for (int k = 0; k < 4; ++k) sfr[p][nt][k] = *(const bf16x8*)(st + (64 * vh + 16 * nt + fr) * 128 + 32 * k + 8 * fq); }
    LBAR(); HOUT_RELANE();
#pragma unroll
    for (int p = 0; p < 2; ++p) { LAS unsigned char* L = L0 + p * HOUT_LDS;
        LAS bf16_t* qh = (LAS bf16_t*)(L + 4096); LAS bf16_t* k0L = (LAS bf16_t*)(L + 4096 + 17408); LAS bf16_t* q1L = (LAS bf16_t*)(L + 4096 + 26112);
        LAS bf16_t* k1L = (LAS bf16_t*)(L + 4096 + 34816); LAS bf16_t* aL = (LAS bf16_t*)(L + 4096 + 61952);
        f32x4 acc = {0.f, 0.f, 0.f, 0.f};
#pragma unroll
        for (int k = 0; k < 4; ++k) { const bf16x8 kf = *(const LAS bf16x8*)(k0L + (16 * sb + fr) * 136 + 32 * k + 8 * fq), qf = *(const LAS bf16x8*)(qh + (16 * tb + fr) * 136 + 32 * k + 8 * fq);
            acc = __builtin_amdgcn_mfma_f32_16x16x32_bf16(kf, qf, acc, 0, 0, 0); }
        const int t = 16 * tb + fr, s0 = 16 * sb + 4 * fq;
#pragma unroll
        for (int j = 0; j < 4; ++j) if (s0 + j > t) acc[j] = 0.f;
        *(LAS u32x2*)(aL + t * 72 + s0) = (u32x2){pk2(acc[0], acc[1]), pk2(acc[2], acc[3])};
        if (wave < 4) { f32x4 ac2 = {0.f, 0.f, 0.f, 0.f};
#pragma unroll
            for (int k = 0; k < 4; ++k) { const bf16x8 kf = *(const LAS bf16x8*)(k1L + (16 * sb + fr) * 136 + 32 * k + 8 * fq), qf = *(const LAS bf16x8*)(q1L + (16 * tb + fr) * 136 + 32 * k + 8 * fq);
                ac2 = __builtin_amdgcn_mfma_f32_16x16x32_bf16(kf, qf, ac2, 0, 0, 0); }
            const int t2 = 32 + 16 * tb + fr, s2 = 32 + 16 * sb + 4 * fq;
#pragma unroll
            for (int j = 0; j < 4; ++j) if (s2 + j > t2) ac2[j] = 0.f;
            *(LAS u32x2*)(aL + t2 * 72 + s2) = (u32x2){pk2(ac2[0], ac2[1]), pk2(ac2[2], ac2[3])};
        } else { const int Lx = (wave - 4) * 64 + lane; unsigned z_; asm volatile("v_mov_b32 %0, 0" : "=v"(z_));
            *(LAS u32x2*)(aL + (Lx >> 3) * 72 + 32 + 4 * (Lx & 7)) = (u32x2){z_, z_}; } }
    LBAR(); HOUT_RELANE();
    f32x4 o[2][4]; u32x2 gbr[2][4];
#pragma unroll
    for (int p = 0; p < 2; ++p) { LAS unsigned char* L = L0 + p * HOUT_LDS;
        LAS float* ssL = (LAS float*)(L + 2048); LAS bf16_t* qh = (LAS bf16_t*)(L + 4096); LAS bf16_t* vT = (LAS bf16_t*)(L + 4096 + 43520); LAS bf16_t* aL = (LAS bf16_t*)(L + 4096 + 61952);
        bf16x8 af[2], qf[4];
#pragma unroll
        for (int k = 0; k < 2; ++k) af[k] = *(const LAS bf16x8*)(aL + (16 * tb + fr) * 72 + 32 * k + 8 * fq);
#pragma unroll
        for (int k = 0; k < 4; ++k) qf[k] = *(const LAS bf16x8*)(qh + (16 * tb + fr) * 136 + 32 * k + 8 * fq);
        float ss = 0.f;
#pragma unroll
        for (int nt = 0; nt < 4; ++nt) { const int v0 = 64 * vh + 16 * nt; f32x4 acc = {0.f, 0.f, 0.f, 0.f};
#pragma unroll
            for (int k = 0; k < 2; ++k) { const bf16x8 vf = *(const LAS bf16x8*)(vT + (v0 + fr) * 72 + 32 * k + 8 * fq); acc = __builtin_amdgcn_mfma_f32_16x16x32_bf16(vf, af[k], acc, 0, 0, 0); }
#pragma unroll
            for (int k = 0; k < 4; ++k) acc = __builtin_amdgcn_mfma_f32_16x16x32_bf16(sfr[p][nt][k], qf[k], acc, 0, 0, 0);
            o[p][nt] = acc; ss += (acc[0] * acc[0] + acc[1] * acc[1]) + (acc[2] * acc[2] + acc[3] * acc[3]); }
        ss += __shfl_xor(ss, 16); ss += __shfl_xor(ss, 32);
        if (fq == 0) ssL[(16 * tb + fr) * 2 + vh] = ss; }
#pragma unroll
    for (int p = 0; p < 2; ++p) { const size_t tok = (size_t)(t0[p] + 16 * tb + fr);
#pragma unroll
        for (int nt = 0; nt < 4; ++nt) gbr[p][nt] = *(const u32x2*)(P + tok * DIN + 1536 + h[p] * 128 + 64 * vh + 16 * nt + 4 * fq); }
    LBAR(); HOUT_RELANE();
#pragma unroll
    for (int p = 0; p < 2; ++p) { LAS float* ssL = (LAS float*)(L0 + p * HOUT_LDS + 2048);
        const float rinv = rsqrtf((ssL[(16 * tb + fr) * 2] + ssL[(16 * tb + fr) * 2 + 1]) * (1.f / 128.f) + EPS);
        const size_t tok = (size_t)(t0[p] + 16 * tb + fr);
#pragma unroll
        for (int nt = 0; nt < 4; ++nt) { const int v0 = 64 * vh + 16 * nt + 4 * fq;
            const u32x2 gb = gbr[p][nt]; const f32x4 hgv = *(const f32x4*)(hg + h[p] * 128 + v0);
            const float g0 = silu_f(bf2f(gb.x & 0xffffu)), g1 = silu_f(__uint_as_float(gb.x & 0xffff0000u)), g2 = silu_f(bf2f(gb.y & 0xffffu)), g3 = silu_f(__uint_as_float(gb.y & 0xffff0000u));
            *(u32x2*)(OC + tok * D + h[p] * 128 + v0) = (u32x2){pk2(o[p][nt][0] * rinv * hgv[0] * g0, o[p][nt][1] * rinv * hgv[1] * g1), pk2(o[p][nt][2] * rinv * hgv[2] * g2, o[p][nt][3] * rinv * hgv[3] * g3)}; } }
}
#undef HOUT_RELANE

typedef float f32x16 __attribute__((ext_vector_type(16)));
#define MFMA32(a, b, c) __builtin_amdgcn_mfma_f32_32x32x16_bf16((a), (b), (c), 0, 0, 0)
__device__ __forceinline__ void attn_unit(LAS unsigned char* L, const bf16_t* Q, const bf16_t* Kl, const bf16_t* VTl, bf16_t* AO, int unit, int tid, int wave, int lane) {
    const int bh = unit >> 5, qb = unit & 31, b = bh >> 2, h = bh & 3, r = lane & 31, hh = lane >> 5;
    LAS bf16_t* kL = (LAS bf16_t*)L;
    const int frow = tid >> 5, fc16 = tid & 31;
    { const u32x4* src = (const u32x4*)(Kl + (size_t)(b * 256 + 16 * frow) * D + h * 256) + fc16; u32x4 t[16];
#pragma unroll
      for (int i = 0; i < 16; ++i) t[i] = src[(size_t)i * (D / 8)];
#pragma unroll
      for (int i = 0; i < 16; ++i) *(LAS u32x4*)(kL + (16 * frow + i) * 264 + 8 * fc16) = t[i]; }
    const size_t q0 = (size_t)b * T + (size_t)qb * 256 + 32 * wave;
    bf16x8 qf[16];
#pragma unroll
    for (int ks = 0; ks < 16; ++ks) qf[ks] = *(const bf16x8*)(Q + (q0 + r) * D + h * 256 + 16 * ks + 8 * hh);
    LBAR();
    bf16x8 pA[8], pB[8]; float mA, lA, mB, lB;
#define ATTN_S_HALF(KT0, PF, MX, LS) { f32x16 sacc[4]; \
        _Pragma("unroll") for (int t = 0; t < 4; ++t) _Pragma("unroll") for (int i = 0; i < 16; ++i) sacc[t][i] = 0.f; \
        _Pragma("unroll") for (int ks = 0; ks < 16; ++ks) _Pragma("unroll") for (int t = 0; t < 4; ++t) { \
            const bf16x8 kf = *(const LAS bf16x8*)(kL + (32 * ((KT0) + t) + r) * 264 + 16 * ks + 8 * hh); sacc[t] = MFMA32(kf, qf[ks], sacc[t]); if (t == 3) __builtin_amdgcn_sched_barrier(0); } \
        float mx_ = -3.0e38f; \
        _Pragma("unroll") for (int t = 0; t < 4; ++t) _Pragma("unroll") for (int i = 0; i < 16; ++i) mx_ = fmaxf(mx_, sacc[t][i]); \
        mx_ = fmaxf(mx_, __shfl_xor(mx_, 32)); const float mb_ = mx_ * LOG2E; float ls_ = 0.f; \
        _Pragma("unroll") for (int t = 0; t < 4; ++t) _Pragma("unroll") for (int i = 0; i < 16; ++i) { const float p_ = __builtin_amdgcn_exp2f(sacc[t][i] * LOG2E - mb_); sacc[t][i] = p_; ls_ += p_; } \
        ls_ += __shfl_xor(ls_, 32); MX = mx_; LS = ls_; \
        _Pragma("unroll") for (int t = 0; t < 4; ++t) _Pragma("unroll") for (int s = 0; s < 2; ++s) { \
            const u32x4 w_ = {pk2(sacc[t][8 * s], sacc[t][8 * s + 1]), pk2(sacc[t][8 * s + 2], sacc[t][8 * s + 3]), pk2(sacc[t][8 * s + 4], sacc[t][8 * s + 5]), pk2(sacc[t][8 * s + 6], sacc[t][8 * s + 7])}; \
            PF[t * 2 + s] = __builtin_bit_cast(bf16x8, w_); } }
    ATTN_S_HALF(0, pA, mA, lA)
    ATTN_S_HALF(4, pB, mB, lB)
#undef ATTN_S_HALF
    const float mm = fmaxf(mA, mB), eA = __builtin_amdgcn_exp2f((mA - mm) * LOG2E), eB = __builtin_amdgcn_exp2f((mB - mm) * LOG2E);
    const float linv = 1.f / (lA * eA + lB * eB), cA = eA * linv, cB = eB * linv;
    LBAR();
    { const u32x4* src = (const u32x4*)(VTl + (size_t)(h * 256 + 16 * frow) * MM + b * 256) + fc16; u32x4 t[16];
#pragma unroll
      for (int i = 0; i < 16; ++i) t[i] = src[(size_t)i * (MM / 8)];
#pragma unroll
      for (int i = 0; i < 16; ++i) { LAS bf16_t* d = kL + (16 * frow + i) * 264 + 16 * (fc16 >> 1) + ((fc16 & 1) ? 4 : 0);
          *(LAS u32x2*)d = (u32x2){t[i].x, t[i].y}; *(LAS u32x2*)(d + 8) = (u32x2){t[i].z, t[i].w}; } }
    LBAR();
    bf16_t* orow = AO + (q0 + r) * D + h * 256 + 4 * hh;
#pragma unroll 2
    for (int dt = 0; dt < 8; ++dt) { f32x16 oa, ob;
#pragma unroll
        for (int i = 0; i < 16; ++i) { oa[i] = 0.f; ob[i] = 0.f; }
        const LAS bf16_t* vrow = kL + (32 * dt + r) * 264 + 8 * hh;
#pragma unroll
        for (int k = 0; k < 8; ++k) { const bf16x8 va = *(const LAS bf16x8*)(vrow + 16 * k), vb = *(const LAS bf16x8*)(vrow + 128 + 16 * k);
            oa = MFMA32(va, pA[k], oa); ob = MFMA32(vb, pB[k], ob); if (k & 1) __builtin_amdgcn_sched_barrier(0); }
#pragma unroll
        for (int g = 0; g < 4; ++g) { const float o0 = oa[4 * g] * cA + ob[4 * g] * cB, o1 = oa[4 * g + 1] * cA + ob[4 * g + 1] * cB, o2 = oa[4 * g + 2] * cA + ob[4 * g + 2] * cB, o3 = oa[4 * g + 3] * cA + ob[4 * g + 3] * cB;
            *(u32x2*)(orow + 32 * dt + 8 * g) = (u32x2){pk2(o0, o1), pk2(o2, o3)}; }
    }
    LBAR();
}

#define RLX_AGENT __ATOMIC_RELAXED, __HIP_MEMORY_SCOPE_AGENT
#define XB_TMO      128
#define XB_XCNT(j)  (256  + 64 * (j))
#define XB_XSUB(j)  (1280 + 64 * (j))
#define XB_XGEN(j)  (2304 + 64 * (j))
#define XB_TOP      3328
#define XB_TOPGEN   3392
#define XCD_BAR_WORDS 3456
#define XB_SPIN_CAP (1u << 18)

__device__ __forceinline__ unsigned xb_ld(unsigned* p)              { return __hip_atomic_load(p, __ATOMIC_RELAXED, __HIP_MEMORY_SCOPE_AGENT); }
__device__ __forceinline__ unsigned xb_add(unsigned* p, unsigned v) { return __hip_atomic_fetch_add(p, v, __ATOMIC_RELAXED, __HIP_MEMORY_SCOPE_AGENT); }
__device__ __forceinline__ unsigned xb_xcc_id() { return (unsigned)__builtin_amdgcn_s_getreg((3 << 11) | 20) & 0xFu; }
#define XB_SPIN(cond, bar) do { unsigned _sp = 0; while (cond) { __builtin_amdgcn_s_sleep(1); \
    if ((++_sp & 255u) == 0u) { if (xb_ld(&(bar)[XB_TMO])) break; if (_sp > XB_SPIN_CAP) { atomicAdd(&(bar)[XB_TMO], 1u); break; } } } } while (0)

struct XcdBarrier {
    unsigned* bar; unsigned x;
    volatile LAS unsigned* st;
};

__device__ __forceinline__ XcdBarrier xcd_barrier_post(unsigned* bar, volatile LAS unsigned* st) {
    XcdBarrier b; b.bar = bar; b.x = xb_xcc_id(); b.st = st;
    if (threadIdx.x == 0) (void)xb_add(&bar[XB_XCNT(b.x)], 1u);
    return b;
}
__device__ __forceinline__ void xcd_barrier_complete(unsigned* bar, unsigned x, unsigned& nloc, unsigned& nx) {
    const unsigned G = gridDim.x * gridDim.y * gridDim.z;
    unsigned sum, cnt, mine, sp = 0u;
    for (;;) {
        sum = 0u; cnt = 0u; mine = 0u;
#pragma unroll
        for (unsigned j = 0; j < 16; ++j) { const unsigned c = xb_ld(&bar[XB_XCNT(j)]); sum += c; cnt += (c > 0u) ? 1u : 0u; mine = (j == x) ? c : mine; }
        if (sum == G) break;
        __builtin_amdgcn_s_sleep(1);
        if ((++sp & 255u) == 0u) { if (xb_ld(&bar[XB_TMO])) break; if (sp > XB_SPIN_CAP) { atomicAdd(&bar[XB_TMO], 1u); break; } }
    }
    nloc = mine > 0u ? mine : 1u; nx = cnt > 0u ? cnt : 1u;
}

__device__ __forceinline__ void xcd_barrier(const XcdBarrier& b) {
    asm volatile("s_waitcnt vmcnt(0)" ::: "memory");
    __syncthreads();
    if (threadIdx.x == 0) {
        unsigned* bar = b.bar;
        __builtin_amdgcn_s_waitcnt(0);
        unsigned nloc = b.st[0], nx = b.st[1];
        if (nloc == 0u) { xcd_barrier_complete(bar, b.x, nloc, nx); b.st[0] = nloc; b.st[1] = nx; }
        const unsigned old = xb_add(&bar[XB_XSUB(b.x)], 1u);
        const unsigned gen = old / nloc;
        if (old + 1u == (gen + 1u) * nloc) {
            __builtin_amdgcn_fence(__ATOMIC_RELEASE, "agent");
            asm volatile("s_waitcnt vmcnt(0)" ::: "memory");
            const unsigned og = xb_add(&bar[XB_TOP], 1u);
            const unsigned tg = og / nx;
            if (og + 1u == (tg + 1u) * nx) xb_add(&bar[XB_TOPGEN], 1u);
            else XB_SPIN(xb_ld(&bar[XB_TOPGEN]) == tg, bar);
            __builtin_amdgcn_fence(__ATOMIC_ACQUIRE, "agent");
            xb_add(&bar[XB_XGEN(b.x)], 1u);
            asm volatile("s_waitcnt vmcnt(0)" ::: "memory");
        } else {
            XB_SPIN(xb_ld(&bar[XB_XGEN(b.x)]) == gen, bar);
            __builtin_amdgcn_fence(__ATOMIC_ACQUIRE, "agent");
            asm volatile("s_waitcnt vmcnt(0)" ::: "memory");
        }
    }
    __syncthreads();
}

__global__ void __launch_bounds__(512, 2) hymba_fwd(Args a) {
    extern __shared__ __attribute__((aligned(16))) unsigned char lds_raw[];
    LAS unsigned char* L = (LAS unsigned char*)lds_raw;
    const int G = gridDim.x, bx = blockIdx.x, vcu = (G % 8 == 0) ? (bx % 8) * (G / 8) + bx / 8 : bx;
    const int NGW = G * 8;
    unsigned char* ws = a.ws;
    const int lo = a.ph_lo, hi = a.ph_hi;
    int pc = 0;
    volatile LAS unsigned* MISC = (volatile LAS unsigned*)(L + LDS_BYTES - 64);
    if (threadIdx.x < 16) MISC[threadIdx.x] = 0u;
    __syncthreads();
    const XcdBarrier bar = xcd_barrier_post((unsigned*)(a.ws + WS_CTL), MISC);
#define GRID_BAR() do { if (pc == 1) cg::this_grid().sync(); else xcd_barrier(bar); } while (0)
#define PH_BEGIN if (pc >= lo && pc < hi) { int tid = threadIdx.x; asm volatile("" : "+v"(tid)); const int lane = tid & 63, wave = __builtin_amdgcn_readfirstlane(tid >> 6), gw = vcu * 8 + wave; (void)lane; (void)gw;
#define PH_END } { ++pc; if (pc > lo && pc < hi) GRID_BAR(); }
#define GEMM_STATIC(EPI, Aptr, Btptr, Mv, Nv, Kv, Eobj) do { pg8::Gemm g_{(const bf16_t*)(Aptr), (const bf16_t*)(Btptr), Mv, Nv, Kv}; pg8::StaticOrder S_; S_.init(Mv, Nv, G, bx); \
        pg8::gemm_phase<EPI, pg8::StaticOrder, true, true>(L, g_, S_, Eobj); } while (0)

    PH_BEGIN p0_prologue(a, L, vcu, G, tid, wave, lane); PH_END
    PH_BEGIN
        for (int it = bx; it < 128; it += G) { const int gi = it >> 4, tile = it & 15, l = gi >> 1, isv = gi & 1;
            const bf16_t* mn = (const bf16_t*)(ws + WS_MEMN) + (size_t)l * MM * D; const bf16_t* wkv = (const bf16_t*)(ws + WS_WKV) + (size_t)l * 2048 * D;
            pg8::Gemm g_{isv ? wkv + (size_t)1024 * D : mn, isv ? mn : wkv, 1024, 1024, 1024};
            SingleUnit S_{tile >> 2, tile & 3};
            EpiScale<false> E_{(bf16_t*)(ws + (isv ? WS_VTB : WS_KB)) + (size_t)l * MM * D, 1024, nullptr, L};
            pg8::gemm_phase<EpiScale<false>, SingleUnit, false, true>(L, g_, S_, E_); }
    PH_END
    for (int l = 0; l < DEPTH; ++l) {
        size_t zoff = 0; int bx = blockIdx.x;
        asm volatile("" : "+s"(zoff), "+s"(bx));
        unsigned char* ws = a.ws + zoff;
        bf16_t* XB = (bf16_t*)(ws + WS_XB); float* PART = (float*)(ws + WS_PART);
        bf16_t* R1 = (bf16_t*)(ws + WS_R1); bf16_t* SB = (bf16_t*)(ws + WS_SBUF); bf16_t* OC = (bf16_t*)(ws + WS_OCAT); float* DB = (float*)(ws + WS_DBUF);
        if (l > 0) { PH_BEGIN conv_layer(a, l, (LAS float*)(L + wave * 16384), gw, NGW, lane); PH_END }
        PH_BEGIN { EpiSwiglu E_{R1, PART, L}; GEMM_STATIC(EpiSwiglu, XB, ws + WS_W13A, M, 2 * FF, D, E_); } PH_END
        PH_BEGIN { EpiResid E_{XB, PART, 0.5f}; GEMM_STATIC(EpiResid, R1, ws + WS_W2A, M, D, FF, E_); } PH_END
        PH_BEGIN { EpiScale<true> E_{R1, DIN, PART, L}; GEMM_STATIC(EpiScale<true>, XB, ws + WS_WIN, M, DIN, D, E_); } PH_END
        PH_BEGIN
            if (G == 256) {
                unsigned za[16], va[16], ua[20], zb[16], vb[16], ub[20];
                e_pair_load(R1, vcu, vcu, tid, za, va, ua);
                for (int i = 0; i < 8; i += 2) {
                    { const int un = vcu + (i + 1) * 256; e_pair_load(R1, un, un, tid, zb, vb, ub); }
                    { const int u = vcu + i * 256; e_unit_pair(L, (const float*)(ws + WS_LB) + l * 512, SB, DB, (const bf16_t*)(ws + WS_POOLT), a.in[11] + l * 512, OC, u, u, tid, wave, lane, za, va, ua); LBAR(); }
                    { const int un = vcu + (i + 2 < 8 ? i + 2 : 7) * 256; e_pair_load(R1, un, un, tid, za, va, ua); }
                    { const int u = vcu + (i + 1) * 256; e_unit_pair(L, (const float*)(ws + WS_LB) + l * 512, SB, DB, (const bf16_t*)(ws + WS_POOLT), a.in[11] + l * 512, OC, u, u, tid, wave, lane, zb, vb, ub); LBAR(); }
                }
            } else for (int u = vcu; u < 2048; u += G) { unsigned za[16], va[16], ua[20];
                e_pair_load(R1, u, u, tid, za, va, ua);
                e_unit_pair(L, (const float*)(ws + WS_LB) + l * 512, SB, DB, (const bf16_t*)(ws + WS_POOLT), a.in[11] + l * 512, OC, u, u, tid, wave, lane, za, va, ua);
                LBAR(); }
        PH_END
        PH_BEGIN hgrn_scan(SB, DB, vcu, G, tid); PH_END
        PH_BEGIN
            for (int u = vcu; u < 2048; u += 2 * G) { hgrn_out_pair(L, R1, (const float*)(ws + WS_LB) + l * 512, SB, a.in[9] + l * 512, OC, u, u + G, tid, wave, lane); LBAR(); }
        PH_END
        PH_BEGIN { EpiResid E_{XB, PART, 1.f}; GEMM_STATIC(EpiResid, OC, ws + WS_WOUT, M, D, D, E_); } PH_END
        PH_BEGIN
            { EpiScale<true> E_{R1, D, PART, L}; GEMM_STATIC(EpiScale<true>, XB, ws + WS_WQ, M, D, D, E_); }
            asm volatile("s_waitcnt vmcnt(0)" ::: "memory"); __syncthreads(); __builtin_amdgcn_fence(__ATOMIC_ACQUIRE, "agent");
            { pg8::StaticOrder S_; S_.init(M, D, G, bx); pg8::Unit u_; int tid = threadIdx.x; asm volatile("" : "+v"(tid)); const int lane = tid & 63, wave = __builtin_amdgcn_readfirstlane(tid >> 6);
              for (int i = 0; S_.next(i, u_); ++i)
                  attn_unit(L, R1, (const bf16_t*)(ws + WS_KB) + (size_t)l * MM * D, (const bf16_t*)(ws + WS_VTB) + (size_t)l * MM * D, R1 + (size_t)M * D, (((u_.pm >> 5) * 4 + u_.pn) << 5) + (u_.pm & 31), tid, wave, lane); }
        PH_END
        PH_BEGIN { EpiResid E_{XB, PART, 1.f}; GEMM_STATIC(EpiResid, R1 + (size_t)M * D, ws + WS_WO, M, D, D, E_); } PH_END
        PH_BEGIN { EpiSwiglu E_{R1, PART, L}; GEMM_STATIC(EpiSwiglu, XB, ws + WS_W13B, M, 2 * FF, D, E_); } PH_END
        PH_BEGIN { EpiResid E_{XB, PART, 0.5f}; GEMM_STATIC(EpiResid, R1, ws + WS_W2B, M, D, FF, E_); } PH_END
    }
    PH_BEGIN
        const bf16_t* XBf = (const bf16_t*)(ws + WS_XB); const float* PART = (const float*)(ws + WS_PART);
        for (int m = gw; m < M; m += NGW) { const float rs = row_rstd(PART, m); f32x4* orow = (f32x4*)(a.out + (size_t)m * D) + lane; const f32x4* g = (const f32x4*)a.in[22] + lane;
            const u32x2* xr = (const u32x2*)(XBf + (size_t)m * D) + lane;
#pragma unroll
            for (int j = 0; j < 4; ++j) { const u32x2 w = xr[64 * j]; const f32x4 v = {bf2f(w.x & 0xffffu), __uint_as_float(w.x & 0xffff0000u), bf2f(w.y & 0xffffu), __uint_as_float(w.y & 0xffff0000u)};
                orow[64 * j] = v * rs * g[64 * j]; } }
    PH_END
}

extern "C" void kernel_launch(void* const* d_in, const int* in_sizes, int n_in, void* d_out, int out_size, void* d_ws, size_t ws_size, hipStream_t stream) {
    static int grid = 0;
    if (grid == 0) {
        int dev = 0, cus = 0, per_cu = 0;
        if (n_in != 23 || ws_size < WS_END) { fprintf(stderr, "kernel_launch: unexpected n_in %d / ws %zu\n", n_in, ws_size); grid = -1; return; }
        hipGetDevice(&dev); hipDeviceGetAttribute(&cus, hipDeviceAttributeMultiprocessorCount, dev);
        if (hipFuncSetAttribute((const void*)hymba_fwd, hipFuncAttributeMaxDynamicSharedMemorySize, LDS_BYTES) != hipSuccess) { fprintf(stderr, "kernel_launch: hipFuncSetAttribute failed\n"); grid = -1; return; }
        hipOccupancyMaxActiveBlocksPerMultiprocessor(&per_cu, (const void*)hymba_fwd, 512, LDS_BYTES);
        (void)hipGetLastError();
        if (per_cu < 1) fprintf(stderr, "kernel_launch: occupancy query says %d\n", per_cu);
        grid = cus > 0 ? cus : 256;
    }
    if (grid < 0) return;
    if (hipMemsetAsync((char*)d_ws + WS_CTL, 0, 16384, stream) != hipSuccess) { fprintf(stderr, "kernel_launch: memset failed\n"); return; }
    Args a{};
    for (int i = 0; i < 23; ++i) a.in[i] = (const float*)d_in[i];
    a.out = (float*)d_out; a.ws = (unsigned char*)d_ws;
    a.ph_lo = 0; a.ph_hi = NPHASE;
    void* args[] = {&a};
    hipError_t e = hipLaunchCooperativeKernel((const void*)hymba_fwd, dim3(grid), dim3(512), args, LDS_BYTES, stream);
    if (e != hipSuccess) fprintf(stderr, "cooperative launch failed: %s (grid %d)\n", hipGetErrorString(e), grid);
}
```
